# Optimizing an MI355X kernel written in HIP

```python
import jax, jax.numpy as jnp
from jax import lax
import numpy as np

D_MODEL = 1024
BATCH = 16
SEQ = 2048
DEPTH = 1

MEM_LEN = 256
EPS = 1e-6
ROPE_THETA = 10000.0
HG_HEADS = 4
HG_DK = 128
HG_DV = 128
HG_WIDTH = HG_HEADS * HG_DK
HG_CHUNK = 64
DSA_HEADS = 8
DSA_Q_LORA = 256
DSA_KV_LORA = 128
DSA_NOPE = 64
DSA_ROPE = 32
DSA_VDIM = 64
DSA_WIDTH = DSA_HEADS * DSA_VDIM
IDX_HEADS = 8
IDX_DIM = 64
TOPK_MAX = 256
Q_BLOCK = 128
MEM_HEADS = 4
MEM_DH = 128
MEM_WIDTH = MEM_HEADS * MEM_DH
D_FF = 4 * D_MODEL
N_BRANCH = 3
IN_SPLITS = (HG_WIDTH, HG_WIDTH, HG_WIDTH, HG_WIDTH,
             DSA_Q_LORA, DSA_KV_LORA, DSA_ROPE, IDX_DIM, IDX_HEADS,
             MEM_WIDTH,
             N_BRANCH * D_MODEL)
IN_WIDTH = sum(IN_SPLITS)

kernel_name = 'hybrid_hgrn2_dsa_memxattn_block'


def rmsnorm(x, w):
    x32 = x.astype(jnp.float32)
    y = x32 * lax.rsqrt(jnp.mean(x32 * x32, axis=-1, keepdims=True) + EPS)
    return (y * w.astype(jnp.float32)).astype(x.dtype)


def rope(x, pos):
    d = x.shape[-1]
    inv = ROPE_THETA ** (-jnp.arange(0, d, 2, dtype=jnp.float32) / d)
    ang = pos.astype(jnp.float32)[:, None] * inv[None, :]
    cos = jnp.cos(ang)[None, :, None, :]
    sin = jnp.sin(ang)[None, :, None, :]
    x32 = x.astype(jnp.float32)
    x1, x2 = x32[..., : d // 2], x32[..., d // 2:]
    return jnp.concatenate([x1 * cos - x2 * sin, x2 * cos + x1 * sin], axis=-1).astype(x.dtype)


def hgrn2_mix(q, f_logit, v, lb):
    B, T, _ = q.shape
    nc = T // HG_CHUNK
    f = lb + (1.0 - lb) * jax.nn.sigmoid(f_logit.astype(jnp.float32))
    log_f = jnp.log(f)
    k = 1.0 - f

    def to_chunks(a, d):
        return a.astype(jnp.float32).reshape(B, nc, HG_CHUNK, HG_HEADS, d).transpose(1, 0, 3, 2, 4)

    qc, kc, vc = to_chunks(q, HG_DK), to_chunks(k, HG_DK), to_chunks(v, HG_DV)
    bc = jnp.cumsum(to_chunks(log_f, HG_DK), axis=3)
    causal = jnp.tril(jnp.ones((HG_CHUNK, HG_CHUNK), dtype=bool))

    def step(S, inp):
        q_, k_, v_, b_ = inp
        o_inter = jnp.einsum('bhtk,bhkv->bhtv', q_ * jnp.exp(b_), S)
        diff = b_[:, :, :, None, :] - b_[:, :, None, :, :]
        decay = jnp.exp(jnp.where(causal[:, :, None], diff, -jnp.inf))
        A = jnp.einsum('bhtk,bhsk,bhtsk->bhts', q_, k_, decay)
        o = o_inter + jnp.einsum('bhts,bhsv->bhtv', A, v_)
        b_last = b_[:, :, -1:, :]
        S_new = (jnp.exp(b_last[:, :, 0, :])[..., None] * S
                 + jnp.einsum('bhsk,bhsv->bhkv', k_ * jnp.exp(b_last - b_), v_))
        return S_new, o

    S0 = jnp.zeros((B, HG_HEADS, HG_DK, HG_DV), jnp.float32)
    _, o = lax.scan(step, S0, (qc, kc, vc, bc))
    return o.transpose(1, 0, 3, 2, 4).reshape(B, T, HG_HEADS, HG_DV).astype(q.dtype)


def dsa_mix(c_q, c_kv, k_rope, k_idx, w_idx, pos, w_uq, w_qr, w_uk, w_uv, w_qidx, topk):
    B, T, _ = c_q.shape
    q_nope = jnp.einsum('btc,chn->bthn', c_q, w_uq)
    q_rope = rope(jnp.einsum('btc,chr->bthr', c_q, w_qr), pos)
    q_abs = jnp.einsum('bthn,hnc->bthc', q_nope, w_uk)
    q_cat = jnp.concatenate([q_abs, q_rope], axis=-1)
    q_idx = rope(jnp.einsum('btc,chd->bthd', c_q, w_qidx), pos)
    k_rope = rope(k_rope[:, :, None, :], pos)[:, :, 0]
    k_idx = rope(k_idx[:, :, None, :], pos)[:, :, 0]
    kv = jnp.concatenate([c_kv, k_rope], axis=-1)
    scale = (DSA_NOPE + DSA_ROPE) ** -0.5
    nb = T // Q_BLOCK
    key_pos = jnp.arange(T, dtype=jnp.int32)

    def blocks(a):
        return a.reshape(B, nb, Q_BLOCK, *a.shape[2:]).swapaxes(0, 1)

    def one_block(inp):
        qc_, qi_, wi_, tpos = inp
        s = jax.nn.relu(jnp.einsum('bthd,bsd->bths', qi_, k_idx).astype(jnp.float32) * IDX_DIM ** -0.5)
        score = jnp.einsum('bths,bth->bts', s, wi_.astype(jnp.float32) * IDX_HEADS ** -0.5)
        causal = key_pos[None, :] <= tpos[:, None]
        score = jnp.where(causal[None], score, -jnp.inf)
        _, idx = lax.top_k(score, topk)
        valid = idx <= tpos[None, :, None]
        sel = jax.vmap(lambda kv_b, idx_b: kv_b[idx_b])(kv, idx)
        logits = jnp.einsum('bthc,btkc->bthk', qc_, sel).astype(jnp.float32) * scale
        logits = jnp.where(valid[:, :, None, :], logits, -jnp.inf)
        p = jax.nn.softmax(logits, axis=-1).astype(sel.dtype)
        return jnp.einsum('bthk,btkc->bthc', p, sel[..., :DSA_KV_LORA])

    o_lat = lax.map(one_block, (blocks(q_cat), blocks(q_idx), blocks(w_idx), pos.reshape(nb, Q_BLOCK)))
    o_lat = o_lat.swapaxes(0, 1).reshape(B, T, DSA_HEADS, DSA_KV_LORA)
    return jnp.einsum('bthc,hcv->bthv', o_lat, w_uv).reshape(B, T, DSA_WIDTH)


def mem_cross(q, mem, mem_norm_w, w_mem_kv):
    B, T, _ = q.shape
    mn = rmsnorm(mem, mem_norm_w)
    kvm = mn @ w_mem_kv
    k_m = kvm[..., :MEM_WIDTH].reshape(B, -1, MEM_HEADS, MEM_DH)
    v_m = kvm[..., MEM_WIDTH:].reshape(B, -1, MEM_HEADS, MEM_DH)
    q_m = q.reshape(B, T, MEM_HEADS, MEM_DH)
    logits = jnp.einsum('bthd,bmhd->bhtm', q_m, k_m).astype(jnp.float32) * MEM_DH ** -0.5
    p = jax.nn.softmax(logits, axis=-1).astype(v_m.dtype)
    return jnp.einsum('bhtm,bmhd->bthd', p, v_m).reshape(B, T, MEM_WIDTH)


def setup_inputs(seed: int = 0) -> dict:
    key = jax.random.key(seed)
    ks = jax.random.split(key, 32)
    f32 = jnp.float32

    def nrm(k, shape, fan_in):
        return jax.random.normal(k, shape, f32) * fan_in ** -0.5

    def gain(k, shape):
        return 1.0 + 0.05 * jax.random.normal(k, shape, f32)

    L = DEPTH
    return {
        'x': jax.random.normal(ks[0], (BATCH, SEQ, D_MODEL), f32),
        'mem': jax.random.normal(ks[1], (BATCH, MEM_LEN, D_MODEL), f32),
        'attn_norm_w': gain(ks[2], (L, D_MODEL)),
        'w_in': nrm(ks[3], (L, D_MODEL, IN_WIDTH), D_MODEL),
        'hgrn_lower_bounds': 0.5 * jax.random.normal(ks[4], (L + 1, HG_WIDTH), f32),
        'hgrn_out_norm_w': gain(ks[5], (L, HG_WIDTH)),
        'dsa_q_norm_w': gain(ks[6], (L, DSA_Q_LORA)),
        'dsa_kv_norm_w': gain(ks[7], (L, DSA_KV_LORA)),
        'dsa_kidx_norm_w': gain(ks[8], (L, IDX_DIM)),
        'dsa_w_uq': nrm(ks[9], (L, DSA_Q_LORA, DSA_HEADS, DSA_NOPE), DSA_Q_LORA),
        'dsa_w_qr': nrm(ks[10], (L, DSA_Q_LORA, DSA_HEADS, DSA_ROPE), DSA_Q_LORA),
        'dsa_w_uk': nrm(ks[11], (L, DSA_HEADS, DSA_NOPE, DSA_KV_LORA), DSA_NOPE),
        'dsa_w_uv': nrm(ks[12], (L, DSA_HEADS, DSA_KV_LORA, DSA_VDIM), DSA_KV_LORA),
        'dsa_w_qidx': nrm(ks[13], (L, DSA_Q_LORA, IDX_HEADS, IDX_DIM), DSA_Q_LORA),
        'mem_norm_w': gain(ks[14], (L, D_MODEL)),
        'w_mem_kv': nrm(ks[15], (L, D_MODEL, 2 * MEM_WIDTH), D_MODEL),
        'w_br_hgrn': nrm(ks[16], (L, HG_WIDTH, D_MODEL), HG_WIDTH),
        'w_br_dsa': nrm(ks[17], (L, DSA_WIDTH, D_MODEL), DSA_WIDTH),
        'w_br_mem': nrm(ks[18], (L, MEM_WIDTH, D_MODEL), MEM_WIDTH),
        'w_out': nrm(ks[19], (L, D_MODEL, D_MODEL), D_MODEL),
        'mlp_norm_w': gain(ks[20], (L, D_MODEL)),
        'w_mlp_up': nrm(ks[21], (L, D_MODEL, D_FF), D_MODEL),
        'w_mlp_down': nrm(ks[22], (L, D_FF, D_MODEL), D_FF),
        'final_norm_w': gain(ks[23], (D_MODEL,)),
    }


def reference(x, mem, attn_norm_w, w_in, hgrn_lower_bounds, hgrn_out_norm_w, dsa_q_norm_w, dsa_kv_norm_w,
              dsa_kidx_norm_w, dsa_w_uq, dsa_w_qr, dsa_w_uk, dsa_w_uv, dsa_w_qidx, mem_norm_w, w_mem_kv,
              w_br_hgrn, w_br_dsa, w_br_mem, w_out, mlp_norm_w, w_mlp_up, w_mlp_down, final_norm_w):
    B, T, D = x.shape
    pos = jnp.arange(T, dtype=jnp.int32)
    topk = min(TOPK_MAX, T // 4)
    split_at = [int(s) for s in np.cumsum(IN_SPLITS)[:-1]]
    lb_all = jnp.cumsum(jax.nn.softmax(hgrn_lower_bounds.astype(jnp.float32), axis=0), axis=0)
    h = x
    for l in range(DEPTH):
        xn = rmsnorm(h, attn_norm_w[l])
        proj = xn @ w_in[l]
        hq, hf, hv, hg, cq, ckv, kr, kidx, widx, mq, gate_logits = jnp.split(proj, split_at, axis=-1)
        o_a = hgrn2_mix(hq, hf, hv, lb_all[l])
        o_a = rmsnorm(o_a, hgrn_out_norm_w[l].reshape(HG_HEADS, HG_DV)) * jax.nn.silu(hg.reshape(B, T, HG_HEADS, HG_DV))
        o_a = o_a.reshape(B, T, HG_WIDTH)
        o_b = dsa_mix(rmsnorm(cq, dsa_q_norm_w[l]), rmsnorm(ckv, dsa_kv_norm_w[l]), kr,
                      rmsnorm(kidx, dsa_kidx_norm_w[l]), widx, pos,
                      dsa_w_uq[l], dsa_w_qr[l], dsa_w_uk[l], dsa_w_uv[l], dsa_w_qidx[l], topk)
        o_c = mem_cross(mq, mem, mem_norm_w[l], w_mem_kv[l])
        gates = jax.nn.sigmoid(gate_logits).reshape(B, T, N_BRANCH, D)
        merged = (gates[:, :, 0] * (o_a @ w_br_hgrn[l])
                  + gates[:, :, 1] * (o_b @ w_br_dsa[l])
                  + gates[:, :, 2] * (o_c @ w_br_mem[l]))
        h = h + merged @ w_out[l]
        m = rmsnorm(h, mlp_norm_w[l])
        h = h + jnp.square(jax.nn.relu(m @ w_mlp_up[l])) @ w_mlp_down[l]
    return rmsnorm(h, final_norm_w)
```

```cpp
constexpr int P0_TW = 6;
#include <hip/hip_runtime.h>
#include <cstdio>
#include <cstdint>

#define LAS __attribute__((address_space(3)))
#define GAS __attribute__((address_space(1)))
typedef unsigned short bf16_t;
typedef short bf16x8 __attribute__((ext_vector_type(8)));
typedef float f32x4 __attribute__((ext_vector_type(4)));
typedef float f32x2 __attribute__((ext_vector_type(2)));
typedef unsigned u32x4 __attribute__((ext_vector_type(4)));
typedef unsigned u32x2 __attribute__((ext_vector_type(2)));
typedef unsigned char uchar;
typedef int i32x4_t __attribute__((ext_vector_type(4)));

constexpr int NB = 16, SEQ = 2048, DM = 1024, MTOK = NB * SEQ, MEMLEN = 256, MMEM = NB * MEMLEN;
constexpr int NIN = 6144;
constexpr int DFF = 4096;
constexpr float EPS = 1e-6f;
constexpr float LOG2E = 1.4426950408889634f;
constexpr int NWAVES = 8, NTHR = 512;
constexpr int LDS_BYTES = 163840;
constexpr int MISC_OFF = LDS_BYTES - 256;

constexpr size_t MiB = 1u << 20;
constexpr size_t WS_CTL = 0, CTL_ZERO_BYTES = 1 * MiB;
constexpr size_t WS_WIN = 1 * MiB;
constexpr size_t WS_W8 = 7 * MiB;
constexpr size_t WS_W8P = 1 * MiB;
constexpr size_t WS_SWP = 10 * MiB + 16384;
constexpr size_t WS_SW = 10 * MiB;
constexpr size_t WS_SXQ = 10 * MiB + 65536;
constexpr size_t WS_SWU = 10 * MiB + 32768;
constexpr size_t WS_WDQ = 13 * MiB;
constexpr size_t WS_WKV = 14 * MiB;
constexpr size_t WS_BALL = 16 * MiB;
constexpr size_t WS_WOUT = 20 * MiB;
constexpr size_t WS_WUP = 22 * MiB;
constexpr size_t WS_WDOWN = 30 * MiB;
constexpr size_t WS_WUVT = 38 * MiB + 786432;
constexpr size_t WS_TAB32 = 38 * MiB;
constexpr size_t WS_TAB64 = WS_TAB32 + 262144;
constexpr size_t WS_RSX = 39 * MiB;
constexpr size_t WS_RSM = WS_RSX + 131072;
constexpr size_t WS_LB = WS_RSM + 16384;
constexpr size_t WS_XCH = 39 * MiB + 262144;
constexpr size_t WS_S2 = 39 * MiB + 786432;
constexpr size_t WS_CQSS = 40 * MiB;
constexpr size_t WS_WIDX = WS_CQSS + 524288;
constexpr size_t WS_H1SS = 42 * MiB;
constexpr size_t WS_XB = 44 * MiB;
constexpr size_t WS_MB = 108 * MiB;
constexpr size_t WS_G = 116 * MiB;
constexpr size_t WS_HV = 180 * MiB;
constexpr size_t WS_REG = 244 * MiB, ARENA = 32 * MiB;
constexpr size_t WS_GATES = WS_REG;
constexpr size_t WS_QI = WS_REG + 12 * MiB;
constexpr size_t WS_HQ = WS_REG + 16 * MiB;
constexpr size_t WS_R9 = WS_REG + 20 * MiB;
constexpr size_t WS_QR = WS_REG + 24 * MiB;
constexpr size_t WS_CQ = WS_REG + 26 * MiB;
constexpr size_t WS_KV = WS_REG + 28 * MiB;
constexpr size_t WS_KIDX = WS_REG + 29 * MiB + 524288;
constexpr size_t WS_KM = WS_REG + 30 * MiB;
__host__ __device__ constexpr size_t xs_bytes(size_t rowbytes, size_t rows_per_group = 4096) { return ARENA - rows_per_group * rowbytes; }
constexpr size_t XS_GATES = xs_bytes(3072), XS_QI = xs_bytes(1024) / 2, XS_HQ = xs_bytes(1024) / 2, XS_R9 = xs_bytes(1024) / 4, XS_QR = xs_bytes(512) / 2, XS_CQ = xs_bytes(512) / 2,
                 XS_KV = xs_bytes(320) / 2, XS_KIDX = xs_bytes(128) / 2, XS_KM = xs_bytes(2048, 512) / 2;
constexpr size_t WS_MERGED = 116 * MiB;
constexpr size_t WS_H1B = 180 * MiB;
constexpr size_t WS_U = 244 * MiB;
constexpr size_t WS_END = 500 * MiB;
static_assert(WS_REG + 8 * ARENA == WS_END, "arena map");
constexpr int GATE_TILES_P2 = 6;
constexpr int CW_BAR = 4096;
constexpr int CW_W8DONE = 81920;
constexpr int CW_COLMAXP = 75776;
constexpr int CW_COLMAXU = 69632;
constexpr int CW_COLMAX = 65536;

typedef __bf16 bf16x2_t __attribute__((ext_vector_type(2)));
__device__ __forceinline__ unsigned cvt_pk_bf16(float lo, float hi) { const f32x2 v = {lo, hi}; const bf16x2_t b = __builtin_convertvector(v, bf16x2_t); return __builtin_bit_cast(unsigned, b); }
__device__ __forceinline__ float bf_lo(unsigned u) { return __uint_as_float(u << 16); }
__device__ __forceinline__ float bf_hi(unsigned u) { return __uint_as_float(u & 0xffff0000u); }
__device__ __forceinline__ float fast_exp(float x) { return __builtin_amdgcn_exp2f(x * LOG2E); }
__device__ __forceinline__ float fast_sigmoid(float x) { return __builtin_amdgcn_rcpf(1.0f + fast_exp(-x)); }
__device__ __forceinline__ f32x4 mma16(bf16x8 rowop, bf16x8 colop, f32x4 c) { return __builtin_amdgcn_mfma_f32_16x16x32_bf16(rowop, colop, c, 0, 0, 0); }
__device__ __forceinline__ int fresh_lane() { unsigned m = ~0u; asm volatile("" : "+s"(m)); int l = __builtin_amdgcn_mbcnt_hi(m, __builtin_amdgcn_mbcnt_lo(m, 0u)); asm volatile("" : "+v"(l)); return l; }
__device__ __forceinline__ float shx(float v, int o, int lane) { return __uint_as_float((unsigned)__builtin_amdgcn_ds_bpermute((lane ^ o) << 2, (int)__float_as_uint(v))); }
__device__ __forceinline__ unsigned shxu(unsigned v, int o, int lane) { return (unsigned)__builtin_amdgcn_ds_bpermute((lane ^ o) << 2, (int)v); }
__device__ __forceinline__ float shdn(float v, int o, int lane) { const int p = lane + o < 64 ? lane + o : lane; return __uint_as_float((unsigned)__builtin_amdgcn_ds_bpermute(p << 2, (int)__float_as_uint(v))); }
__device__ __forceinline__ unsigned shdnu(unsigned v, int o, int lane) { const int p = lane + o < 64 ? lane + o : lane; return (unsigned)__builtin_amdgcn_ds_bpermute(p << 2, (int)v); }
#define LDS_WAIT() asm volatile("s_waitcnt lgkmcnt(0)" ::: "memory")
#define VM_WAIT() asm volatile("s_waitcnt vmcnt(0)" ::: "memory")
__device__ __forceinline__ int sw256(int row, int ch) { return row * 256 + ((ch ^ (row & 15)) << 4); }
__device__ __forceinline__ int sw128(int row, int ch) { return row * 128 + ((ch ^ ((row >> 1) & 7)) << 4); }
__device__ __forceinline__ int sw64(int row, int ch) { return row * 64 + ((ch ^ ((0x78 >> (((row >> 2) & 3) * 2)) & 3)) << 4); }

namespace pg8 {
constexpr int BM = 256, BK = 64, HALF = 128, HTB = HALF * BK * 2, STAGE_BYTES = 8 * HTB, NXCD = 8, WGM = 8;
__host__ __device__ __forceinline__ int lds_byte(int r, int c) { const int st = (r >> 4) * 2 + (c >> 5), rr = r & 15, cc = c & 31, ob = rr * 64 + cc * 2; return st * 1024 + (ob ^ (((ob >> 9) & 1) << 5)); }
__host__ __device__ __forceinline__ void stage_rc(int b, int& R, int& C) { const int st = b / 1024, sb = b % 1024, swz = sb ^ (((sb >> 9) & 1) << 5); R = (st >> 1) * 16 + swz / 64; C = (st & 1) * 32 + (swz % 64) / 2; }
__host__ __device__ __forceinline__ int perm32(int rho) { const int n = rho >> 4, i = rho & 15; return 8 * (i >> 2) + 4 * n + (i & 3); }

struct Unit { int pm, pn, k0, nt, tag; };
struct Gemm { const bf16_t* A; const bf16_t* Bt; int lda, ldb; size_t axs = 0; };

__device__ __forceinline__ void tile_of(int L, int nM, int nN, int& pm, int& pn) {
    const int nwg = nM * nN; int wgid = L;
    { const int q = nwg / NXCD, r = nwg % NXCD, xcd = wgid % NXCD, off = wgid / NXCD; wgid = (xcd < r ? xcd * (q + 1) : r * (q + 1) + (xcd - r) * q) + off; }
    const int nig = WGM * nN, gid = wgid / nig, fm = gid * WGM, gsz = (nM - fm) < WGM ? (nM - fm) : WGM;
    pm = fm + ((wgid % nig) % gsz); pn = (wgid % nig) / gsz;
}
struct TileSched {
    int nM, nN, pn0, G, c, nt;
    __device__ __forceinline__ bool next(int i, Unit& u) const {
        const long L = (long)i * G + c; if (c < 0 || L >= (long)nM * nN) return false;
        int pm, pn; tile_of((int)L, nM, nN, pm, pn); u.pm = pm; u.pn = pn + pn0; u.k0 = 0; u.nt = nt; u.tag = 0; return true;
    }
};
struct XcdSched {
    bool xm; TileSched t; int x, r, nr, npm, npn, pn0, nt;
    __device__ __forceinline__ bool next(int i, Unit& u) const {
        if (!xm) return t.next(i, u);
        const int q = i * nr + r; if (r < 0 || q >= npm * npn) return false;
        u.pm = npm * x + q % npm; u.pn = pn0 + q / npm; u.k0 = 0; u.nt = nt; u.tag = 0; return true;
    }
};
struct GateSched {
    bool xm; TileSched t; int x, r2;
    __device__ __forceinline__ bool next(int i, Unit& u) const {
        if (!xm) return t.next(i, u);
        if (i >= 8) return false;
        u.pm = 16 * x + 4 * (i & 3) + (r2 & 3); u.pn = 6 * (i >> 2) + (r2 >> 2); u.k0 = 0; u.nt = 8; u.tag = 0; return true;
    }
};
struct ProjSched {
    TileSched t;
    __device__ __forceinline__ bool next(int i, Unit& u) const { if (!t.next(i, u)) return false; if (u.pn >= 8) u.pn += 2; return true; }
};
struct UpSched {
    bool xm; TileSched t; int x, rk;
    __device__ __forceinline__ bool next(int i, Unit& u) const {
        if (!xm) return t.next(i, u);
        if (i >= 8) return false;
        const int idx = ((i & 4) | ((i + x) & 3)) * 32 + rk;
        u.pm = 16 * x + 8 * (idx >> 7) + (idx & 7); u.pn = (idx & 127) >> 3; u.k0 = 0; u.nt = 8; u.tag = 0; return true;
    }
};
struct MergeSched {
    int G, c;
    __device__ __forceinline__ bool next(int i, Unit& u) const {
        const int ti = i / 3, s = i - 3 * ti; const long L = (long)ti * G + c; if (L >= 512) return false;
        const int sub = s;
        int pm, pn; tile_of((int)L, 128, 4, pm, pn); u.pm = pm; u.pn = pn; u.tag = sub | (sub < 2 ? 32 : 0);
        u.k0 = sub == 0 ? 0 : (sub == 1 ? 512 : 1536); u.nt = 8; return true;
    }
};

#define PG8_LAS LAS
typedef int i32x4 __attribute__((ext_vector_type(4)));
template <bool I8> __device__ __forceinline__ f32x4 mma_sel(bf16x8 b, bf16x8 a, f32x4 c) {
    if constexpr (I8) return __builtin_bit_cast(f32x4, __builtin_amdgcn_mfma_i32_16x16x64_i8(__builtin_bit_cast(i32x4, b), __builtin_bit_cast(i32x4, a), __builtin_bit_cast(i32x4, c), 0, 0, 0));
    else return __builtin_amdgcn_mfma_f32_16x16x32_bf16(b, a, c, 0, 0, 0);
}
template <class Epi, class Sched>
__device__ __forceinline__ void gemm_phase(PG8_LAS unsigned char* lds, const int wid, const Gemm g, const Sched& S, const Epi& E) {
    const int lane = fresh_lane(), tid = wid * 64 + lane, wr = wid >> 2, wc = wid & 3, fr = lane & 15, fq = lane >> 4;
    unsigned voffA[2], voffB[2];
#pragma unroll
    for (int i = 0; i < 2; ++i) { int R, C; stage_rc(tid * 16 + i * 8192, R, C); const int Rb = Epi::PERM ? ((R & ~31) + perm32(R & 31)) : R;
        voffA[i] = (unsigned)(R * g.lda + C) * 2u; voffB[i] = (unsigned)(Rb * g.ldb + C) * 2u; }
    const size_t kstep = (size_t)(BK * 2);
    const size_t hstepA = (size_t)HALF * g.lda * 2, hstepB = (size_t)HALF * g.ldb * 2;
    const size_t tstepA = 2 * hstepA, tstepB = 2 * hstepB;
    const unsigned ldsw = (unsigned)wid * 1024u;
    const int aoff = lds_byte(wr * 64 + fr, fq * 8), boff = lds_byte(wc * 32 + fr, fq * 8);
#define PG8_SA(b, h) (((b) * 2 + (h)) * HTB)
#define PG8_SB(b, h) ((4 + (b) * 2 + (h)) * HTB)
#define PG8_STAGE(bufoff, gbase, voff) do { _Pragma("unroll") for (int _i = 0; _i < 2; ++_i) \
        __builtin_amdgcn_global_load_lds((const unsigned*)((const char*)(gbase) + (voff)[_i]), (PG8_LAS unsigned*)(lds + (bufoff) + ldsw + _i * 8192), 16, 0, 0); } while (0)
#define PG8_LDA(dst, b, h) do { _Pragma("unroll") for (int m = 0; m < 4; ++m) _Pragma("unroll") for (int k = 0; k < 2; ++k) dst[m][k] = *(const PG8_LAS bf16x8*)(lds + PG8_SA(b, h) + aoff + m * 2048 + k * 1024); } while (0)
#define PG8_LDB(dst, b, h) do { _Pragma("unroll") for (int n = 0; n < 2; ++n) _Pragma("unroll") for (int k = 0; k < 2; ++k) dst[n][k] = *(const PG8_LAS bf16x8*)(lds + PG8_SB(b, h) + boff + n * 2048 + k * 1024); } while (0)
#define PG8_MMA(ai, bj, At, Bt) do { __builtin_amdgcn_s_setprio(1); _Pragma("unroll") for (int m = 0; m < 4; ++m) _Pragma("unroll") for (int n = 0; n < 2; ++n) _Pragma("unroll") for (int k = 0; k < 2; ++k) \
        acc[ai][bj][m][n] = mma_sel<Epi::I8>(Bt[n][k], At[m][k], acc[ai][bj][m][n]); __builtin_amdgcn_s_setprio(0); } while (0)
#define PG8_WAIT_V(n) asm volatile("s_waitcnt vmcnt(" #n ")" ::: "memory")
#define PG8_WAIT_L(n) asm volatile("s_waitcnt lgkmcnt(" #n ")" ::: "memory")
#define PG8_BAR __builtin_amdgcn_s_barrier()
#define PG8_SCHED __builtin_amdgcn_sched_barrier(0)
    Unit cur, nxt; int ui = 0;
    if (!S.next(0, cur)) return;
    f32x4 acc[2][2][4][2];
#pragma unroll
    for (int a = 0; a < 2; ++a)
#pragma unroll
        for (int b = 0; b < 2; ++b)
#pragma unroll
            for (int m = 0; m < 4; ++m)
#pragma unroll
                for (int n = 0; n < 2; ++n) acc[a][b][m][n] = (f32x4){0.f, 0.f, 0.f, 0.f};
    bf16x8 At[4][2], B0[2][2], B1[2][2];
    const char* cA = (const char*)g.A + (size_t)cur.pm * tstepA + (size_t)(cur.pm >> 4) * g.axs + (size_t)cur.k0 * 2; const char* cB = (const char*)g.Bt + (size_t)cur.pn * tstepB + (size_t)cur.k0 * 2;
    {
        PG8_STAGE(PG8_SB(0, 0), cB, voffB); PG8_STAGE(PG8_SB(0, 1), cB + hstepB, voffB); PG8_STAGE(PG8_SA(0, 0), cA, voffA); PG8_STAGE(PG8_SA(0, 1), cA + hstepA, voffA);
        if (wr == 1) PG8_BAR;
        PG8_WAIT_V(2); PG8_BAR;
        PG8_STAGE(PG8_SB(1, 0), cB + kstep, voffB); PG8_STAGE(PG8_SA(1, 0), cA + kstep, voffA); PG8_STAGE(PG8_SB(1, 1), cB + hstepB + kstep, voffB);
        PG8_WAIT_V(6); PG8_BAR;
    }
    for (;;) {
        const bool has_next = S.next(ui + 1, nxt);
        const char* nA = has_next ? (const char*)g.A + (size_t)nxt.pm * tstepA + (size_t)(nxt.pm >> 4) * g.axs + (size_t)nxt.k0 * 2 : cA; const char* nB = has_next ? (const char*)g.Bt + (size_t)nxt.pn * tstepB + (size_t)nxt.k0 * 2 : cB;
        const int nt = cur.nt;
        for (int t = 0; t < nt; t += 2) {
            const bool last = (t == nt - 2);
            const char* a1 = cA + (size_t)(t + 1) * kstep;
            const char* a2 = last ? nA : cA + (size_t)(t + 2) * kstep; const char* b2 = last ? nB : cB + (size_t)(t + 2) * kstep;
            const char* a3 = a2 + kstep; const char* b3 = b2 + kstep;
            PG8_LDB(B0, 0, 0); PG8_LDB(B1, 0, 1); PG8_SCHED; PG8_LDA(At, 0, 0); PG8_STAGE(PG8_SA(1, 1), a1 + hstepA, voffA);
            PG8_WAIT_V(8); PG8_WAIT_L(0); PG8_BAR; PG8_MMA(0, 0, At, B0); PG8_MMA(0, 1, At, B1); PG8_BAR; PG8_SCHED;
            PG8_LDA(At, 0, 1); PG8_STAGE(PG8_SB(0, 0), b2, voffB); PG8_STAGE(PG8_SB(0, 1), b2 + hstepB, voffB); PG8_STAGE(PG8_SA(0, 0), a2, voffA);
            PG8_WAIT_V(8); PG8_WAIT_L(0); PG8_BAR; PG8_MMA(1, 0, At, B0); PG8_MMA(1, 1, At, B1); PG8_BAR; PG8_SCHED;
            PG8_LDB(B0, 1, 0); PG8_LDB(B1, 1, 1); PG8_SCHED; PG8_LDA(At, 1, 0); PG8_STAGE(PG8_SA(0, 1), a2 + hstepA, voffA);
            PG8_WAIT_V(8); PG8_WAIT_L(0); PG8_BAR; PG8_MMA(0, 0, At, B0); PG8_MMA(0, 1, At, B1); PG8_BAR; PG8_SCHED;
            PG8_LDA(At, 1, 1); PG8_STAGE(PG8_SB(1, 0), b3, voffB); PG8_STAGE(PG8_SB(1, 1), b3 + hstepB, voffB); PG8_STAGE(PG8_SA(1, 0), a3, voffA);
            PG8_WAIT_V(8); PG8_WAIT_L(0); PG8_BAR; PG8_MMA(1, 0, At, B0); PG8_MMA(1, 1, At, B1); PG8_BAR; PG8_SCHED;
        }
        if (wr == 0) PG8_BAR;
        E(acc, cur, wr, wc, fr, fq);
        if (!has_next) break;
        if (!(Epi::FUSE && (cur.tag & 32))) {
#pragma unroll
        for (int a = 0; a < 2; ++a)
#pragma unroll
            for (int b = 0; b < 2; ++b)
#pragma unroll
                for (int m = 0; m < 4; ++m)
#pragma unroll
                    for (int n = 0; n < 2; ++n) acc[a][b][m][n] = (f32x4){0.f, 0.f, 0.f, 0.f};
        }
        cur = nxt; cA = nA; cB = nB; ++ui;
        if (wr == 1) PG8_BAR;
    }
    PG8_WAIT_V(0);
    PG8_BAR;
#undef PG8_SA
#undef PG8_SB
#undef PG8_STAGE
#undef PG8_LDA
#undef PG8_LDB
#undef PG8_MMA
#undef PG8_WAIT_V
#undef PG8_WAIT_L
#undef PG8_BAR
#undef PG8_SCHED
}
}
using pg8::Unit;

#define XLANE (fq * 16 + fr)
#define EPI_ROWS_BEGIN _Pragma("unroll") for (int ai = 0; ai < 2; ++ai) _Pragma("unroll") for (int m = 0; m < 4; ++m) { const int row = u.pm * 256 + ai * 128 + wr * 64 + m * 16 + fr;
#define EPI_ROWS_END }
__device__ __forceinline__ u32x4 pack8(const f32x4 a, const f32x4 b) { u32x4 w; w.x = cvt_pk_bf16(a[0], a[1]); w.y = cvt_pk_bf16(a[2], a[3]); w.z = cvt_pk_bf16(b[0], b[1]); w.w = cvt_pk_bf16(b[2], b[3]); return w; }

struct EpiProj {
    static constexpr bool PERM = true; static constexpr bool FUSE = false; static constexpr bool I8 = false;
    const float* rsx; bf16_t* oall; bf16_t* hq; float* G; bf16_t* hv; bf16_t* sg; bf16_t* cq; float* cqss; float* r9; uchar* gates; const float* lb;
    __device__ __forceinline__ void operator()(const f32x4 (&acc)[2][2][4][2], const Unit& u, int wr, int wc, int fr, int fq) const {
        const int pn = u.pn; const int cw = wc * 32 + 8 * fq; const size_t xg = (size_t)(u.pm >> 4);
        float rsv[2][4];
#pragma unroll
        for (int ai = 0; ai < 2; ++ai)
#pragma unroll
            for (int m = 0; m < 4; ++m) rsv[ai][m] = rsx[u.pm * 256 + ai * 128 + wr * 64 + m * 16 + fr];
        if (pn < 2 || (pn >= 4 && pn < 8) || pn == 10 || pn == 11) {
            bf16_t* base; int ld, c0; int mode = 0; float sc = 1.f;
            if (pn < 2) { base = hq + xg * XS_HQ; ld = 512; c0 = pn * 256; }
            else if (pn < 6) { base = hv; ld = 1024; c0 = (pn - 4) * 256; }
            else if (pn < 8) { base = hv; ld = 1024; c0 = 512 + (pn - 6) * 256; mode = 1; }
            else { base = oall; ld = 2048; c0 = 1536 + (pn - 10) * 256; sc = 0.08838834764831845f * LOG2E; }
            EPI_ROWS_BEGIN const float rs = rsv[ai][m] * sc;
#pragma unroll
                for (int bj = 0; bj < 2; ++bj) { f32x4 v0 = acc[ai][bj][m][0] * rs, v1 = acc[ai][bj][m][1] * rs;
                    if (mode == 1) {
#pragma unroll
                        for (int e = 0; e < 4; ++e) { v0[e] = v0[e] * fast_sigmoid(v0[e]); v1[e] = v1[e] * fast_sigmoid(v1[e]); } }
                    *(u32x4*)(base + (size_t)row * ld + c0 + bj * 128 + cw) = pack8(v0, v1); }
            EPI_ROWS_END
        } else if (pn < 4) {
            f32x4 lbv[2][2];
#pragma unroll
            for (int bj = 0; bj < 2; ++bj) { const int ch = (pn - 2) * 256 + bj * 128 + cw; lbv[bj][0] = *(const f32x4*)(lb + ch); lbv[bj][1] = *(const f32x4*)(lb + ch + 4); }
            EPI_ROWS_BEGIN const float rs = rsv[ai][m];
#pragma unroll
                for (int bj = 0; bj < 2; ++bj) { const int ch = (pn - 2) * 256 + bj * 128 + cw; const f32x4 l0 = lbv[bj][0], l1 = lbv[bj][1];
                    f32x4 v0 = acc[ai][bj][m][0] * rs, v1 = acc[ai][bj][m][1] * rs;
#pragma unroll
                    for (int e = 0; e < 4; ++e) { v0[e] = __logf(l0[e] + (1.f - l0[e]) * fast_sigmoid(v0[e])); v1[e] = __logf(l1[e] + (1.f - l1[e]) * fast_sigmoid(v1[e])); }
                    float* p = G + (size_t)row * 512 + ch; *(f32x4*)p = v0; *(f32x4*)(p + 4) = v1; }
            EPI_ROWS_END
        } else if (pn == 8) {
            EPI_ROWS_BEGIN const float rs = rsv[ai][m]; float ss = 0.f;
#pragma unroll
                for (int bj = 0; bj < 2; ++bj) { const f32x4 v0 = acc[ai][bj][m][0] * rs, v1 = acc[ai][bj][m][1] * rs;
#pragma unroll
                    for (int e = 0; e < 4; ++e) ss += v0[e] * v0[e] + v1[e] * v1[e];
                    *(u32x4*)(cq + xg * XS_CQ + (size_t)row * 256 + bj * 128 + cw) = pack8(v0, v1); }
                ss += shx(ss, 16, XLANE); ss += shx(ss, 32, XLANE);
                if (fq == 0) cqss[row * 4 + wc] = ss;
            EPI_ROWS_END
        } else if (pn == 9) {
            EPI_ROWS_BEGIN const float rs = rsv[ai][m];
#pragma unroll
                for (int bj = 0; bj < 2; ++bj) { float* p = r9 + xg * XS_R9 + (size_t)row * 256 + bj * 128 + cw; *(f32x4*)p = acc[ai][bj][m][0] * rs; *(f32x4*)(p + 4) = acc[ai][bj][m][1] * rs; }
            EPI_ROWS_END
        } else {
            const int c0 = (pn - 12) * 256;
            EPI_ROWS_BEGIN const float rs = rsv[ai][m];
#pragma unroll
                for (int bj = 0; bj < 2; ++bj) { const f32x4 v0 = acc[ai][bj][m][0] * rs, v1 = acc[ai][bj][m][1] * rs; unsigned q[8];
#pragma unroll
                    for (int e = 0; e < 4; ++e) { q[e] = (unsigned)fmaxf(255.f * fast_sigmoid(v0[e]) + 0.5f, 1.f); q[4 + e] = (unsigned)fmaxf(255.f * fast_sigmoid(v1[e]) + 0.5f, 1.f);     }
                    u32x2 w; w.x = q[0] | (q[1] << 8) | (q[2] << 16) | (q[3] << 24); w.y = q[4] | (q[5] << 8) | (q[6] << 16) | (q[7] << 24);
                    *(u32x2*)(gates + xg * XS_GATES + (size_t)row * 3072 + c0 + bj * 128 + cw) = w; }
            EPI_ROWS_END
        }
    }
};
struct EpiProj8 {
    static constexpr bool PERM = true; static constexpr bool FUSE = false; static constexpr bool I8 = true;
    EpiProj base; const float* sxq; const float* swp;
    __device__ __forceinline__ void operator()(f32x4 (&acc)[2][2][4][2], const Unit& u, int wr, int wc, int fr, int fq) const {
        const int cw = wc * 32 + 8 * fq;
        f32x4 swv[2][2];
#pragma unroll
        for (int bj = 0; bj < 2; ++bj) { swv[bj][0] = *(const f32x4*)(swp + u.pn * 256 + bj * 128 + cw); swv[bj][1] = *(const f32x4*)(swp + u.pn * 256 + bj * 128 + cw + 4); }
        EPI_ROWS_BEGIN const float rs = sxq[row];
#pragma unroll
            for (int bj = 0; bj < 2; ++bj) { const i32x4_t a0 = __builtin_bit_cast(i32x4_t, acc[ai][bj][m][0]), a1 = __builtin_bit_cast(i32x4_t, acc[ai][bj][m][1]); f32x4 v0, v1;
#pragma unroll
                for (int e = 0; e < 4; ++e) { v0[e] = (float)a0[e] * rs * swv[bj][0][e]; v1[e] = (float)a1[e] * rs * swv[bj][1][e]; }
                acc[ai][bj][m][0] = v0; acc[ai][bj][m][1] = v1; }
        EPI_ROWS_END
        base(acc, u, wr, wc, fr, fq);
    }
};
struct EpiKvm {
    static constexpr bool PERM = true; static constexpr bool FUSE = false; static constexpr bool I8 = false;
    const float* rsm; bf16_t* km;
    __device__ __forceinline__ void operator()(const f32x4 (&acc)[2][2][4][2], const Unit& u, int wr, int wc, int fr, int fq) const {
        const int cw = u.pn * 256 + wc * 32 + 8 * fq;
        float rsv[2][4];
#pragma unroll
        for (int ai = 0; ai < 2; ++ai)
#pragma unroll
            for (int m = 0; m < 4; ++m) rsv[ai][m] = rsm[u.pm * 256 + ai * 128 + wr * 64 + m * 16 + fr];
        EPI_ROWS_BEGIN const float rs = rsv[ai][m];
#pragma unroll
            for (int bj = 0; bj < 2; ++bj) *(u32x4*)(km + (size_t)(u.pm >> 1) * XS_KM + (size_t)row * 1024 + bj * 128 + cw) = pack8(acc[ai][bj][m][0] * rs, acc[ai][bj][m][1] * rs);
        EPI_ROWS_END
    }
};
struct EpiDq {
    static constexpr bool PERM = true; static constexpr bool FUSE = false; static constexpr bool I8 = false;
    const float* cqss; bf16_t* oall; bf16_t* qr; bf16_t* qi; const float* tab32; const float* tab64;
    __device__ __forceinline__ void operator()(const f32x4 (&acc)[2][2][4][2], const Unit& u, int wr, int wc, int fr, int fq) const {
        const int pn = u.pn; const int cw = wc * 32 + 8 * fq;
#pragma unroll
        for (int ai = 0; ai < 2; ++ai) {
            f32x4 s4[4]; f32x4 cs[4][2][2];
#pragma unroll
            for (int m = 0; m < 4; ++m) { const int row = u.pm * 256 + ai * 128 + wr * 64 + m * 16 + fr; const int t = row & (SEQ - 1); s4[m] = *(const f32x4*)(cqss + (size_t)row * 4);
                if (pn >= 4) {
#pragma unroll
                    for (int bj = 0; bj < 2; ++bj) { const int cc = bj * 128 + cw; const int c5 = (pn - 5) * 256 + cc;
                        const float* tp = (pn == 4) ? tab32 + ((size_t)t * 16 + ((cc & 31) >> 1)) * 2 : tab64 + ((size_t)t * 32 + ((c5 & 63) >> 1)) * 2;
                        cs[m][bj][0] = *(const f32x4*)tp; cs[m][bj][1] = *(const f32x4*)(tp + 4); } } }
#pragma unroll
            for (int m = 0; m < 4; ++m) { const int row = u.pm * 256 + ai * 128 + wr * 64 + m * 16 + fr; const float rs = rsqrtf((s4[m][0] + s4[m][1] + s4[m][2] + s4[m][3]) * (1.f / 256.f) + EPS);
#pragma unroll
                for (int bj = 0; bj < 2; ++bj) { f32x4 v0 = acc[ai][bj][m][0] * rs, v1 = acc[ai][bj][m][1] * rs; const int cc = bj * 128 + cw;
                    if (pn < 4) { *(u32x4*)(oall + (size_t)row * 2048 + 512 + pn * 256 + cc) = pack8(v0, v1); }
                    else {
                        bf16_t* op = (pn == 4) ? qr + (size_t)(u.pm >> 4) * XS_QR + (size_t)row * 256 + cc : qi + (size_t)(u.pm >> 4) * XS_QI + (size_t)row * 512 + (pn - 5) * 256 + cc;
                        const f32x4 cs0 = cs[m][bj][0], cs1 = cs[m][bj][1];
                        f32x4 o0, o1;
                        o0[0] = v0[0] * cs0[0] - v0[1] * cs0[1]; o0[1] = v0[1] * cs0[0] + v0[0] * cs0[1];
                        o0[2] = v0[2] * cs0[2] - v0[3] * cs0[3]; o0[3] = v0[3] * cs0[2] + v0[2] * cs0[3];
                        o1[0] = v1[0] * cs1[0] - v1[1] * cs1[1]; o1[1] = v1[1] * cs1[0] + v1[0] * cs1[1];
                        o1[2] = v1[2] * cs1[2] - v1[3] * cs1[3]; o1[3] = v1[3] * cs1[2] + v1[2] * cs1[3];
                        *(u32x4*)op = pack8(o0, o1);
                    } } }
        }
    }
};
struct EpiMerge {
    static constexpr bool PERM = true; static constexpr bool FUSE = true; static constexpr bool I8 = false;
    const uchar* gates; bf16_t* merged;
    __device__ __forceinline__ void operator()(f32x4 (&acc)[2][2][4][2], const Unit& u, int wr, int wc, int fr, int fq) const {
        const int cw = u.pn * 256 + wc * 32 + 8 * fq; const int sub = u.tag & 15;
#pragma unroll
        for (int ai = 0; ai < 2; ++ai) {
            u32x2 gn[4][2], gd[4][2];
#pragma unroll
            for (int m = 0; m < 4; ++m) { const int row = u.pm * 256 + ai * 128 + wr * 64 + m * 16 + fr;
#pragma unroll
                for (int bj = 0; bj < 2; ++bj) { const uchar* gp = gates + (size_t)(u.pm >> 4) * XS_GATES + (size_t)row * 3072 + sub * 1024 + bj * 128 + cw; gn[m][bj] = *(const u32x2*)gp; gd[m][bj] = sub < 2 ? *(const u32x2*)(gp + 1024) : (u32x2){0u, 0u}; } }
#pragma unroll
            for (int m = 0; m < 4; ++m) { const int row = u.pm * 256 + ai * 128 + wr * 64 + m * 16 + fr;
#pragma unroll
                for (int bj = 0; bj < 2; ++bj) { const u32x2 n2 = gn[m][bj], d2 = gd[m][bj];
                    float f[8];
#pragma unroll
                    for (int e = 0; e < 8; ++e) { const float qn = (float)(((e < 4 ? n2.x : n2.y) >> (8 * (e & 3))) & 255u);
                        f[e] = sub < 2 ? qn * __builtin_amdgcn_rcpf((float)(((e < 4 ? d2.x : d2.y) >> (8 * (e & 3))) & 255u)) : qn * (1.f / 255.f); }
                    f32x4 v0 = acc[ai][bj][m][0], v1 = acc[ai][bj][m][1];
                    v0[0] *= f[0]; v0[1] *= f[1]; v0[2] *= f[2]; v0[3] *= f[3]; v1[0] *= f[4]; v1[1] *= f[5]; v1[2] *= f[6]; v1[3] *= f[7];
                    if (sub < 2) { acc[ai][bj][m][0] = v0; acc[ai][bj][m][1] = v1; }
                    else *(u32x4*)(merged + (size_t)row * 1024 + bj * 128 + cw) = pack8(v0, v1); } }
        }
    }
};
struct EpiGate8 {
    static constexpr bool PERM = true; static constexpr bool FUSE = false; static constexpr bool I8 = true;
    const float* rsx; const float* sxq; const float* sw; uchar* gates;
    __device__ __forceinline__ void operator()(const f32x4 (&acc)[2][2][4][2], const Unit& u, int wr, int wc, int fr, int fq) const {
        const int c0 = u.pn * 256, cw = wc * 32 + 8 * fq; const size_t xg = (size_t)(u.pm >> 4);
        f32x4 swv[2][2];
#pragma unroll
        for (int bj = 0; bj < 2; ++bj) { swv[bj][0] = *(const f32x4*)(sw + c0 + bj * 128 + cw); swv[bj][1] = *(const f32x4*)(sw + c0 + bj * 128 + cw + 4); }
        float rsv[2][4];
#pragma unroll
        for (int ai = 0; ai < 2; ++ai)
#pragma unroll
            for (int m = 0; m < 4; ++m) { const int row = u.pm * 256 + ai * 128 + wr * 64 + m * 16 + fr; rsv[ai][m] = rsx[row] * sxq[row]; }
        EPI_ROWS_BEGIN const float rs = rsv[ai][m];
#pragma unroll
            for (int bj = 0; bj < 2; ++bj) { const i32x4_t a0 = __builtin_bit_cast(i32x4_t, acc[ai][bj][m][0]), a1 = __builtin_bit_cast(i32x4_t, acc[ai][bj][m][1]); unsigned q[8];
#pragma unroll
                for (int e = 0; e < 4; ++e) { q[e] = (unsigned)fmaxf(255.f * fast_sigmoid((float)a0[e] * rs * swv[bj][0][e]) + 0.5f, 1.f); q[4 + e] = (unsigned)fmaxf(255.f * fast_sigmoid((float)a1[e] * rs * swv[bj][1][e]) + 0.5f, 1.f); }
                u32x2 w; w.x = q[0] | (q[1] << 8) | (q[2] << 16) | (q[3] << 24); w.y = q[4] | (q[5] << 8) | (q[6] << 16) | (q[7] << 24);
                *(u32x2*)(gates + xg * XS_GATES + (size_t)row * 3072 + c0 + bj * 128 + cw) = w; }
        EPI_ROWS_END
    }
};
struct EpiOut {
    static constexpr bool PERM = true; static constexpr bool FUSE = false; static constexpr bool I8 = false;
    const float* xf; bf16_t* h1b; float* h1ss;
    __device__ __forceinline__ void operator()(const f32x4 (&acc)[2][2][4][2], const Unit& u, int wr, int wc, int fr, int fq) const {
        const int cw = u.pn * 256 + wc * 32 + 8 * fq;
#pragma unroll
        for (int ai = 0; ai < 2; ++ai) {
#pragma unroll
            for (int mp = 0; mp < 2; ++mp) {
            f32x4 xr[2][2][2];
#pragma unroll
            for (int m2 = 0; m2 < 2; ++m2) { const int row = u.pm * 256 + ai * 128 + wr * 64 + (2 * mp + m2) * 16 + fr;
#pragma unroll
                for (int bj = 0; bj < 2; ++bj) { const float* p = xf + (size_t)row * 1024 + bj * 128 + cw; xr[m2][bj][0] = *(const f32x4*)p; xr[m2][bj][1] = *(const f32x4*)(p + 4); } }
#pragma unroll
            for (int m2 = 0; m2 < 2; ++m2) { const int m = 2 * mp + m2; const int row = u.pm * 256 + ai * 128 + wr * 64 + m * 16 + fr; float ss = 0.f;
#pragma unroll
                for (int bj = 0; bj < 2; ++bj) { const size_t off = (size_t)row * 1024 + bj * 128 + cw;
                    f32x4 v0 = acc[ai][bj][m][0] + xr[m2][bj][0], v1 = acc[ai][bj][m][1] + xr[m2][bj][1];
#pragma unroll
                    for (int e = 0; e < 4; ++e) ss += v0[e] * v0[e] + v1[e] * v1[e];
                    *(u32x4*)(h1b + off) = pack8(v0, v1); }
                ss += shx(ss, 16, XLANE); ss += shx(ss, 32, XLANE);
                if (fq == 0) h1ss[(size_t)row * 16 + u.pn * 4 + wc] = ss; }
            }
        }
    }
};
struct EpiUp {
    static constexpr bool PERM = true; static constexpr bool FUSE = false; static constexpr bool I8 = false;
    bf16_t* U; const float* h1ss; float* s2v;
    __device__ __forceinline__ void operator()(const f32x4 (&acc)[2][2][4][2], const Unit& u, int wr, int wc, int fr, int fq) const {
        const int cw = u.pn * 256 + wc * 32 + 8 * fq;
        if (u.pn == 0 && wc == 0 && fq == 0) {
            EPI_ROWS_BEGIN const f32x4* sp = (const f32x4*)(h1ss + (size_t)row * 16); const f32x4 a = sp[0], b = sp[1], c = sp[2], d = sp[3];
                const float tot = ((a[0] + a[1]) + (a[2] + a[3])) + ((b[0] + b[1]) + (b[2] + b[3])) + ((c[0] + c[1]) + (c[2] + c[3])) + ((d[0] + d[1]) + (d[2] + d[3]));
                s2v[row] = 1.f / (tot * (1.f / 1024.f) + EPS);
            EPI_ROWS_END
        }
        EPI_ROWS_BEGIN
#pragma unroll
            for (int bj = 0; bj < 2; ++bj) { f32x4 v0 = acc[ai][bj][m][0], v1 = acc[ai][bj][m][1];
#pragma unroll
                for (int e = 0; e < 4; ++e) { const float a = fmaxf(v0[e], 0.f), b = fmaxf(v1[e], 0.f); v0[e] = a * a; v1[e] = b * b; }
                *(u32x4*)(U + (size_t)row * DFF + bj * 128 + cw) = pack8(v0, v1); }
        EPI_ROWS_END
    }
};
struct EpiUp8 {
    static constexpr bool PERM = true; static constexpr bool FUSE = false; static constexpr bool I8 = true;
    bf16_t* U; const float* h1ss; float* s2v; const float* sa; const float* swc;
    __device__ __forceinline__ void operator()(const f32x4 (&acc)[2][2][4][2], const Unit& u, int wr, int wc, int fr, int fq) const {
        const int cw = u.pn * 256 + wc * 32 + 8 * fq;
        if (u.pn == 0 && wc == 0 && fq == 0) {
            EPI_ROWS_BEGIN const f32x4* sp = (const f32x4*)(h1ss + (size_t)row * 16); const f32x4 a = sp[0], b = sp[1], c = sp[2], d = sp[3];
                const float tot = ((a[0] + a[1]) + (a[2] + a[3])) + ((b[0] + b[1]) + (b[2] + b[3])) + ((c[0] + c[1]) + (c[2] + c[3])) + ((d[0] + d[1]) + (d[2] + d[3]));
                s2v[row] = 1.f / (tot * (1.f / 1024.f) + EPS);
            EPI_ROWS_END
        }
        f32x4 swv[2][2];
#pragma unroll
        for (int bj = 0; bj < 2; ++bj) { swv[bj][0] = *(const f32x4*)(swc + bj * 128 + cw); swv[bj][1] = *(const f32x4*)(swc + bj * 128 + cw + 4); }
        EPI_ROWS_BEGIN const float rs = sa[row];
#pragma unroll
            for (int bj = 0; bj < 2; ++bj) { const i32x4_t a0 = __builtin_bit_cast(i32x4_t, acc[ai][bj][m][0]), a1 = __builtin_bit_cast(i32x4_t, acc[ai][bj][m][1]); f32x4 v0, v1;
#pragma unroll
                for (int e = 0; e < 4; ++e) { const float a = fmaxf((float)a0[e] * rs * swv[bj][0][e], 0.f), b = fmaxf((float)a1[e] * rs * swv[bj][1][e], 0.f); v0[e] = a * a; v1[e] = b * b; }
                *(u32x4*)(U + (size_t)row * DFF + bj * 128 + cw) = pack8(v0, v1); }
        EPI_ROWS_END
    }
};
constexpr int CW_PANEL = 16384;
struct EpiDownNorm {
    static constexpr bool PERM = true; static constexpr bool FUSE = false; static constexpr bool I8 = false;
    float* out; const bf16_t* h1b; const float* s2v; const float* fw; unsigned* xch; unsigned* cnt; LAS uchar* lds;
    __device__ __forceinline__ void operator()(f32x4 (&acc)[2][2][4][2], const Unit& u, int wr, int wc, int fr, int fq) const {
        const int cw = u.pn * 256 + wc * 32 + 8 * fq; const int wid = wr * 4 + wc, tid = wid * 64 + fq * 16 + fr;
        LAS float* P = (LAS float*)lds;
        LAS float* Sc = (LAS float*)(lds + 4096);
#pragma unroll
        for (int ai = 0; ai < 2; ++ai) {
            u32x4 hr[4][2]; float s2r[4];
#pragma unroll
            for (int m = 0; m < 4; ++m) { const int row = u.pm * 256 + ai * 128 + wr * 64 + m * 16 + fr; s2r[m] = s2v[row];
#pragma unroll
                for (int bj = 0; bj < 2; ++bj) hr[m][bj] = *(const u32x4*)(h1b + (size_t)row * 1024 + bj * 128 + cw); }
#pragma unroll
            for (int m = 0; m < 4; ++m) {
                const float s2 = s2r[m]; float ss = 0.f;
#pragma unroll
                for (int bj = 0; bj < 2; ++bj) { const u32x4 r = hr[m][bj];
                    f32x4 o0 = acc[ai][bj][m][0] * s2, o1 = acc[ai][bj][m][1] * s2;
                    o0[0] += bf_lo(r.x); o0[1] += bf_hi(r.x); o0[2] += bf_lo(r.y); o0[3] += bf_hi(r.y); o1[0] += bf_lo(r.z); o1[1] += bf_hi(r.z); o1[2] += bf_lo(r.w); o1[3] += bf_hi(r.w);
#pragma unroll
                    for (int e = 0; e < 4; ++e) ss += o0[e] * o0[e] + o1[e] * o1[e];
                    acc[ai][bj][m][0] = o0; acc[ai][bj][m][1] = o1; }
                ss += shx(ss, 16, XLANE); ss += shx(ss, 32, XLANE);
                if (fq == 0) P[(ai * 128 + wr * 64 + m * 16 + fr) * 4 + wc] = ss; }
        }
        asm volatile("s_waitcnt lgkmcnt(0)" ::: "memory"); __builtin_amdgcn_s_barrier(); asm volatile("" ::: "memory");
        unsigned* slot = xch + ((size_t)u.pm * 4 + u.pn) * 256; unsigned* pc = cnt + 64 * u.pm;
        if (tid < 256) { const f32x4 p4 = *(const LAS f32x4*)(P + tid * 4); __hip_atomic_store(slot + tid, __float_as_uint((p4[0] + p4[1]) + (p4[2] + p4[3])), __ATOMIC_RELAXED, __HIP_MEMORY_SCOPE_AGENT); }
        asm volatile("s_waitcnt vmcnt(0)" ::: "memory");
        __builtin_amdgcn_s_barrier(); asm volatile("" ::: "memory");
        if (tid == 0) __hip_atomic_fetch_add(pc, 1u, __ATOMIC_RELAXED, __HIP_MEMORY_SCOPE_AGENT);
        if (wid == 0) { unsigned sp = 0u;
            while ((unsigned)__builtin_amdgcn_readfirstlane(__hip_atomic_load(pc, __ATOMIC_RELAXED, __HIP_MEMORY_SCOPE_AGENT)) < 4u) { __builtin_amdgcn_s_sleep(2); if (++sp > (1u << 22)) break; }
            __builtin_amdgcn_fence(__ATOMIC_ACQUIRE, "agent"); asm volatile("s_waitcnt vmcnt(0)" ::: "memory"); }
        __builtin_amdgcn_s_barrier(); asm volatile("" ::: "memory");
        if (tid < 256) { const unsigned* s0 = xch + (size_t)u.pm * 4 * 256 + tid; float tt = 0.f;
#pragma unroll
            for (int q = 0; q < 4; ++q) tt += __uint_as_float(__hip_atomic_load(s0 + q * 256, __ATOMIC_RELAXED, __HIP_MEMORY_SCOPE_AGENT));
            Sc[tid] = rsqrtf(tt * (1.f / 1024.f) + EPS); }
        asm volatile("s_waitcnt vmcnt(0) lgkmcnt(0)" ::: "memory"); __builtin_amdgcn_s_barrier(); asm volatile("" ::: "memory");
        EPI_ROWS_BEGIN const float rn = Sc[ai * 128 + wr * 64 + m * 16 + fr];
#pragma unroll
            for (int bj = 0; bj < 2; ++bj) { const int col = bj * 128 + cw; const f32x4 w0 = *(const f32x4*)(fw + col), w1 = *(const f32x4*)(fw + col + 4);
                float* p = out + (size_t)row * 1024 + col; *(f32x4*)p = acc[ai][bj][m][0] * rn * w0; *(f32x4*)(p + 4) = acc[ai][bj][m][1] * rn * w1; }
        EPI_ROWS_END
        asm volatile("s_waitcnt lgkmcnt(0)" ::: "memory"); __builtin_amdgcn_s_barrier(); asm volatile("" ::: "memory");
    }
};

#define XB_TMO      128
#define XB_XCNT(j)  (256  + 64 * (j))
#define XB_XSUB(j)  (1280 + 64 * (j))
#define XB_XGEN(j)  (2304 + 64 * (j))
#define XB_TOP      3328
#define XB_TOPGEN   3392
#define XCD_BAR_WORDS 3456
#define XB_SPIN_CAP (1u << 22)
__device__ __forceinline__ unsigned xb_ld(unsigned* p)              { return __hip_atomic_load(p, __ATOMIC_RELAXED, __HIP_MEMORY_SCOPE_AGENT); }
__device__ __forceinline__ unsigned xb_add(unsigned* p, unsigned v) { return __hip_atomic_fetch_add(p, v, __ATOMIC_RELAXED, __HIP_MEMORY_SCOPE_AGENT); }
__device__ __forceinline__ unsigned xb_xcc_id() { return (unsigned)__builtin_amdgcn_s_getreg((3 << 11) | 20) & 0xFu; }
#define XB_SPIN(cond, bar) do { unsigned _sp = 0; while (cond) { __builtin_amdgcn_s_sleep(1); \
    if ((++_sp & 255u) == 0u) { if (xb_ld(&(bar)[XB_TMO])) break; if (_sp > XB_SPIN_CAP) { atomicAdd(&(bar)[XB_TMO], 1u); break; } } } } while (0)
struct XcdBarrier { unsigned* bar; unsigned x; volatile LAS unsigned* st; };
__device__ __forceinline__ XcdBarrier xcd_barrier_post(unsigned* bar, volatile LAS unsigned* st) {
    XcdBarrier b; b.bar = bar; b.x = xb_xcc_id(); b.st = st;
    if (threadIdx.x == 0) { st[4] = xb_add(&bar[XB_XCNT(b.x)], 1u); st[5] = b.x; }
    return b;
}
__device__ __forceinline__ void xcd_barrier_complete(unsigned* bar, unsigned x, unsigned& nloc, unsigned& nx, unsigned& even32) {
    const unsigned G = gridDim.x * gridDim.y * gridDim.z;
    unsigned sum, cnt, mine, ok, sp = 0u;
    for (;;) {
        sum = 0u; cnt = 0u; mine = 0u; ok = 1u;
#pragma unroll
        for (unsigned j = 0; j < 16; ++j) { const unsigned c = xb_ld(&bar[XB_XCNT(j)]); sum += c; cnt += (c > 0u) ? 1u : 0u; mine = (j == x) ? c : mine; ok &= (c == (j < 8u ? 32u : 0u)) ? 1u : 0u; }
        if (sum == G) break;
        __builtin_amdgcn_s_sleep(1);
        if ((++sp & 255u) == 0u) { if (xb_ld(&bar[XB_TMO])) break; if (sp > XB_SPIN_CAP) { atomicAdd(&bar[XB_TMO], 1u); break; } }
    }
    nloc = mine > 0u ? mine : 1u; nx = cnt > 0u ? cnt : 1u; even32 = (sum == G && G == 256u) ? ok : 0u;
}
__device__ __forceinline__ void xcd_barrier(const XcdBarrier& b, int wave, bool local = false) {
    asm volatile("s_waitcnt vmcnt(0)" ::: "memory");
    __syncthreads();
    if (wave == 0 && fresh_lane() == 0) {
        unsigned* bar = b.bar;
        __builtin_amdgcn_s_waitcnt(0);
        unsigned nloc = b.st[0], nx = b.st[1];
        if (nloc == 0u) { unsigned e32; xcd_barrier_complete(bar, b.x, nloc, nx, e32); b.st[0] = nloc; b.st[1] = nx; b.st[2] = e32; }
        const unsigned old = xb_add(&bar[XB_XSUB(b.x)], 1u);
        const unsigned gen = old / nloc;
        if (old + 1u == (gen + 1u) * nloc) {
            if (!local) {
            __builtin_amdgcn_fence(__ATOMIC_RELEASE, "agent");
            asm volatile("s_waitcnt vmcnt(0)" ::: "memory");
            const unsigned og = xb_add(&bar[XB_TOP], 1u);
            const unsigned tg = og / nx;
            if (og + 1u == (tg + 1u) * nx) xb_add(&bar[XB_TOPGEN], 1u);
            else XB_SPIN(xb_ld(&bar[XB_TOPGEN]) == tg, bar);
            }
            __builtin_amdgcn_fence(__ATOMIC_ACQUIRE, "agent");
            xb_add(&bar[XB_XGEN(b.x)], 1u);
            asm volatile("s_waitcnt vmcnt(0)" ::: "memory");
        } else {
            XB_SPIN(xb_ld(&bar[XB_XGEN(b.x)]) == gen, bar);
            __builtin_amdgcn_fence(__ATOMIC_ACQUIRE, "agent");
            asm volatile("s_waitcnt vmcnt(0)" ::: "memory");
        }
    }
    __syncthreads();
}

struct Args { const float* in[24]; float* out; uchar* ws; };
struct Frame {
    LAS uchar* lds; int wave, G, c, vcu;
    const float* const* in; float* out; uchar* ws;
};
__device__ __forceinline__ float wave_sum(float v, int lane) {
#pragma unroll
    for (int o = 1; o < 64; o <<= 1) v += shx(v, o, lane);
    return v;
}

__device__ __forceinline__ void p0_tr_item(const float* src, int ldsrc, int scol0, int nvalid, const float* kscale, bf16_t* dst, int ldd, int dcol0, int n0, int k0, LAS float* scr, int lane) {
    float tv[32]; const int nn = lane & 31, nc = nn < nvalid ? nn : 0;
#pragma unroll
    for (int i = 0; i < 32; ++i) tv[i] = src[(size_t)(k0 + 2 * i + (lane >> 5)) * ldsrc + scol0 + nc];
#pragma unroll
    for (int i = 0; i < 32; ++i) { const int kk = 2 * i + (lane >> 5); float v = nn < nvalid ? tv[i] : 0.f; if (kscale) v *= kscale[k0 + kk];
        scr[kk * 33 + nn] = v; }
    LDS_WAIT(); asm volatile("" ::: "memory");
    const int c = lane & 7;
#pragma unroll
    for (int j = 0; j < 4; ++j) { const int n = (lane >> 3) + 8 * j; const LAS float* s = scr + (8 * c) * 33 + n;
        u32x4 o; o.x = cvt_pk_bf16(s[0 * 33], s[1 * 33]); o.y = cvt_pk_bf16(s[2 * 33], s[3 * 33]); o.z = cvt_pk_bf16(s[4 * 33], s[5 * 33]); o.w = cvt_pk_bf16(s[6 * 33], s[7 * 33]);
        *(u32x4*)(dst + (size_t)(n0 + n) * ldd + dcol0 + k0 + 8 * c) = o; }
    LDS_WAIT(); asm volatile("" ::: "memory");
}
__device__ __forceinline__ void p0_colmax_item(const float* src, int ldsrc, int scol0, const float* kscale, unsigned* colmax, int k0, int lane) {
    float tv[32]; const int nn = lane & 31;
#pragma unroll
    for (int i = 0; i < 32; ++i) tv[i] = src[(size_t)(k0 + 2 * i + (lane >> 5)) * ldsrc + scol0 + nn];
    float m = 0.f;
#pragma unroll
    for (int i = 0; i < 32; ++i) m = fmaxf(m, fabsf(tv[i] * kscale[k0 + 2 * i + (lane >> 5)]));
    m = fmaxf(m, shx(m, 32, lane));
    if (lane < 32) __hip_atomic_fetch_max(colmax + nn, __float_as_uint(m), __ATOMIC_RELAXED, __HIP_MEMORY_SCOPE_AGENT);
}
__device__ __forceinline__ void p1_w8_items(Frame& F, const float* src, int ldsrc, int scol0, const float* kscale, const unsigned* colmax, int nblk, uchar* W8, float* SW) {
    const int lane = fresh_lane(), nn = lane & 31;
    LAS float* scr = (LAS float*)(F.lds + F.wave * 16384);
    for (int it = F.c * NWAVES + F.wave; it < 16 * nblk; it += F.G * NWAVES) { const int kb = it / nblk, nb = it % nblk, n0 = nb * 32, k0 = kb * 64;
        float tv[32];
#pragma unroll
        for (int i = 0; i < 32; ++i) tv[i] = src[(size_t)(k0 + 2 * i + (lane >> 5)) * ldsrc + scol0 + n0 + nn];
        const float cm = __uint_as_float(__hip_atomic_load(colmax + n0 + nn, __ATOMIC_RELAXED, __HIP_MEMORY_SCOPE_AGENT)); const float inv = cm > 0.f ? 127.f / cm : 0.f;
#pragma unroll
        for (int i = 0; i < 32; ++i) { const int kk = 2 * i + (lane >> 5); scr[kk * 33 + nn] = rintf(tv[i] * kscale[k0 + kk] * inv); }
        LDS_WAIT(); asm volatile("" ::: "memory");
        const int c = lane & 7;
#pragma unroll
        for (int j = 0; j < 4; ++j) { const int n = (lane >> 3) + 8 * j; const LAS float* sp = scr + (8 * c) * 33 + n; unsigned b[8];
#pragma unroll
            for (int e = 0; e < 8; ++e) b[e] = (unsigned)((int)sp[e * 33]) & 255u;
            u32x2 o; o.x = b[0] | (b[1] << 8) | (b[2] << 16) | (b[3] << 24); o.y = b[4] | (b[5] << 8) | (b[6] << 16) | (b[7] << 24);
            *(u32x2*)(W8 + (size_t)(n0 + n) * 1024 + k0 + 8 * c) = o; }
        if (kb == 0 && lane < 32) SW[n0 + nn] = cm * (1.f / 127.f);
        LDS_WAIT(); asm volatile("" ::: "memory");
    }
}
__device__ __forceinline__ void p2_xq_rows(Frame& F, const uchar* srcb, uchar* dstb, int dstride, int row0, int nrows, int wv, int nwv) {
    uchar* ws = F.ws; const int lane = fresh_lane(); float* SXQ = (float*)(ws + WS_SXQ);
    for (int r = row0 + 4 * wv; r < row0 + nrows; r += 4 * nwv) {
        u32x4 lo[4], hi[4]; float am[4];
#pragma unroll
        for (int q = 0; q < 4; ++q) { const u32x4* p = (const u32x4*)(srcb + (size_t)(r + q) * 2048) + 2 * lane; lo[q] = p[0]; hi[q] = p[1]; }
#pragma unroll
        for (int q = 0; q < 4; ++q) { const unsigned wd[8] = {lo[q].x, lo[q].y, lo[q].z, lo[q].w, hi[q].x, hi[q].y, hi[q].z, hi[q].w}; float m = 0.f;
#pragma unroll
            for (int e = 0; e < 8; ++e) m = fmaxf(m, fmaxf(fabsf(bf_lo(wd[e])), fabsf(bf_hi(wd[e]))));
            am[q] = m; }
#pragma unroll
        for (int o = 1; o < 64; o <<= 1) { const float t0 = shx(am[0], o, lane), t1 = shx(am[1], o, lane), t2 = shx(am[2], o, lane), t3 = shx(am[3], o, lane); am[0] = fmaxf(am[0], t0); am[1] = fmaxf(am[1], t1); am[2] = fmaxf(am[2], t2); am[3] = fmaxf(am[3], t3); }
#pragma unroll
        for (int q = 0; q < 4; ++q) { const float inv = am[q] > 0.f ? 127.f / am[q] : 0.f; const unsigned wd[8] = {lo[q].x, lo[q].y, lo[q].z, lo[q].w, hi[q].x, hi[q].y, hi[q].z, hi[q].w}; unsigned ow[4];
#pragma unroll
            for (int e = 0; e < 4; ++e) { const unsigned b0 = (unsigned)((int)rintf(bf_lo(wd[2 * e]) * inv)) & 255u, b1 = (unsigned)((int)rintf(bf_hi(wd[2 * e]) * inv)) & 255u, b2 = (unsigned)((int)rintf(bf_lo(wd[2 * e + 1]) * inv)) & 255u, b3 = (unsigned)((int)rintf(bf_hi(wd[2 * e + 1]) * inv)) & 255u;
                ow[e] = b0 | (b1 << 8) | (b2 << 16) | (b3 << 24); }
            *((u32x4*)(dstb + (size_t)(r + q) * dstride) + lane) = (u32x4){ow[0], ow[1], ow[2], ow[3]};
            if (lane == 0) SXQ[r + q] = am[q] * (1.f / 127.f); }
    }
}
__device__ __forceinline__ void p0_row2(const float* x0, const float* x1, bf16_t* o0, bf16_t* o1, float* rs0, float* rs1, int lane) {
    const f32x4* xa = (const f32x4*)x0 + lane; const f32x4* xb = (const f32x4*)x1 + lane; f32x4 va[4], vb[4];
#pragma unroll
    for (int j = 0; j < 4; ++j) va[j] = xa[64 * j];
#pragma unroll
    for (int j = 0; j < 4; ++j) vb[j] = xb[64 * j];
    float sa = 0.f, sb = 0.f;
#pragma unroll
    for (int j = 0; j < 4; ++j) { sa += (va[j][0] * va[j][0] + va[j][1] * va[j][1]) + (va[j][2] * va[j][2] + va[j][3] * va[j][3]); sb += (vb[j][0] * vb[j][0] + vb[j][1] * vb[j][1]) + (vb[j][2] * vb[j][2] + vb[j][3] * vb[j][3]); }
    u32x2* pa = (u32x2*)o0 + lane; u32x2* pb = (u32x2*)o1 + lane;
#pragma unroll
    for (int j = 0; j < 4; ++j) { u32x2 w; w.x = cvt_pk_bf16(va[j][0], va[j][1]); w.y = cvt_pk_bf16(va[j][2], va[j][3]); pa[64 * j] = w; w.x = cvt_pk_bf16(vb[j][0], vb[j][1]); w.y = cvt_pk_bf16(vb[j][2], vb[j][3]); pb[64 * j] = w; }
    sa = wave_sum(sa, lane); sb = wave_sum(sb, lane);
    if (lane == 0) { *rs0 = rsqrtf(sa * (1.f / 1024.f) + EPS); *rs1 = rsqrtf(sb * (1.f / 1024.f) + EPS); }
}

__device__ __forceinline__ void p0_rows4(const float* src, bf16_t* dst, float* rs, int m0, int mstep, int mend, int lane) {
    if (m0 >= mend) return;
    f32x4 va[16], vb[16];
#define P0_LD(v, m) do { const f32x4* p_ = (const f32x4*)(src + (size_t)(m) * 1024) + lane; _Pragma("unroll") for (int j = 0; j < 16; ++j) v[j] = p_[64 * j]; } while (0)
#define P0_DO(v, m) do { _Pragma("unroll") for (int r = 0; r < 4; ++r) { float sa = 0.f; u32x2* po = (u32x2*)(dst + (size_t)((m) + r) * 1024) + lane; \
        _Pragma("unroll") for (int j = 0; j < 4; ++j) { const f32x4 x = v[4 * r + j]; sa += (x[0] * x[0] + x[1] * x[1]) + (x[2] * x[2] + x[3] * x[3]); u32x2 w; w.x = cvt_pk_bf16(x[0], x[1]); w.y = cvt_pk_bf16(x[2], x[3]); po[64 * j] = w; } \
        sa = wave_sum(sa, lane); if (lane == 0) rs[(m) + r] = rsqrtf(sa * (1.f / 1024.f) + EPS); } } while (0)
    int m = m0; P0_LD(va, m);
    for (;;) {
        int mn = m + mstep; bool more = mn < mend; P0_LD(vb, more ? mn : m);
        P0_DO(va, m); if (!more) break; m = mn;
        mn = m + mstep; more = mn < mend; P0_LD(va, more ? mn : m);
        P0_DO(vb, m); if (!more) break; m = mn;
    }
#undef P0_LD
#undef P0_DO
}

__device__ __forceinline__ void p0_prologue(Frame& F) {
    const float* const* in = F.in; uchar* ws = F.ws;
    LAS float* scr = (LAS float*)(F.lds + F.wave * 16384);
    const int lane = fresh_lane(), tid_ = F.wave * 64 + lane;
    constexpr int TW = P0_TW;
    const bool rowrole = F.wave >= TW;
    const int gw = rowrole ? F.vcu * (8 - TW) + (F.wave - TW) : F.vcu * TW + F.wave, NGW = rowrole ? F.G * (8 - TW) : F.G * TW;
    bf16_t* Win = (bf16_t*)(ws + WS_WIN); bf16_t* Wkv = (bf16_t*)(ws + WS_WKV); bf16_t* Ball = (bf16_t*)(ws + WS_BALL); bf16_t* Wout = (bf16_t*)(ws + WS_WOUT);
    bf16_t* Wup = (bf16_t*)(ws + WS_WUP); bf16_t* Wdown = (bf16_t*)(ws + WS_WDOWN); bf16_t* Wdq = (bf16_t*)(ws + WS_WDQ);
    constexpr int I0 = 16 * 192, I1 = 16 * 32, I2 = 8 * 32, I3 = 8 * 32, I3b = 8 * 32, I4 = 16 * 32, I5 = 16 * 128, I6 = 64 * 32, NIT = I0 + I1 + I2 + I3 + I3b + I4 + I5 + I6;
    if (!rowrole) for (int it = gw; it < NIT; it += NGW) {
        int r = it;
        if (r < I0) { const int kb = r / 192, nb = r % 192, n0 = nb * 32; int sc = n0, nv = 32; if (n0 == 2528) nv = 8; else if (n0 >= 2560) sc = n0 - 24;
            if (n0 >= 3072) p0_colmax_item(in[3], 6120, sc, in[2], (unsigned*)(ws + WS_CTL) + CW_COLMAX + (n0 - 3072), kb * 64, lane);
            else if (n0 < 2048 || n0 >= 2560) p0_colmax_item(in[3], 6120, sc, in[2], (unsigned*)(ws + WS_CTL) + CW_COLMAXP + n0, kb * 64, lane);
            else p0_tr_item(in[3], 6120, sc, nv, in[2], Win, 1024, 0, n0, kb * 64, scr, lane);
            continue; } r -= I0;
        if (r < I1) { p0_tr_item(in[15], 1024, (r % 32) * 32, 32, in[14], Wkv, 1024, 0, (r % 32) * 32, (r / 32) * 64, scr, lane); continue; } r -= I1;
        if (r < I2) { p0_tr_item(in[16], 1024, (r % 32) * 32, 32, nullptr, Ball, 2048, 0, (r % 32) * 32, (r / 32) * 64, scr, lane); continue; } r -= I2;
        if (r < I3) { p0_tr_item(in[18], 1024, (r % 32) * 32, 32, nullptr, Ball, 2048, 1536, (r % 32) * 32, (r / 32) * 64, scr, lane); continue; } r -= I3;
        if (r < I3b) { p0_tr_item(in[17], 1024, (r % 32) * 32, 32, nullptr, Ball, 2048, 512, (r % 32) * 32, (r / 32) * 64, scr, lane); continue; } r -= I3b;
        if (r < I4) { p0_tr_item(in[19], 1024, (r % 32) * 32, 32, nullptr, Wout, 1024, 0, (r % 32) * 32, (r / 32) * 64, scr, lane); continue; } r -= I4;
        if (r < I5) { p0_colmax_item(in[21], 4096, (r % 128) * 32, in[20], (unsigned*)(ws + WS_CTL) + CW_COLMAXU + (r % 128) * 32, (r / 128) * 64, lane); continue; } r -= I5;
        p0_tr_item(in[22], 1024, (r % 32) * 32, 32, nullptr, Wdown, 4096, 0, (r % 32) * 32, (r / 32) * 64, scr, lane);
    }
    if (rowrole) { p0_rows4(in[0], (bf16_t*)(ws + WS_XB), (float*)(ws + WS_RSX), 4 * gw, 4 * NGW, MTOK, lane); p0_rows4(in[1], (bf16_t*)(ws + WS_MB), (float*)(ws + WS_RSM), 4 * gw, 4 * NGW, MMEM, lane); }
    if (rowrole) return;
    const int gt = F.vcu * (TW * 64) + tid_, NGT = F.G * (TW * 64);
    const float* w_uq = in[9]; const float* w_qr = in[10]; const float* w_uk = in[11]; const float* w_uv = in[12]; const float* w_qidx = in[13]; const float* qnw = in[6];
    const float SCL = 0.10206207261596577f * LOG2E;
    for (int e = gt; e < 1792 * 256; e += NGT) {
        const int row = e >> 8, c = e & 255; float v;
        if (row < 1024) { const int h = row >> 7, j = row & 127; float s = 0.f; const float* a = w_uq + (size_t)c * 512 + h * 64; const float* b = w_uk + (size_t)h * 64 * 128 + j;
#pragma unroll 8
            for (int n = 0; n < 64; ++n) s += a[n] * b[n * 128];
            v = s * SCL; }
        else if (row < 1280) { const int r = row - 1024, h = r >> 5, p = r & 31, d = (p >> 1) + 16 * (p & 1); v = w_qr[(size_t)c * 256 + h * 32 + d] * SCL; }
        else { const int r = row - 1280, h = r >> 6, p = r & 63, d = (p >> 1) + 32 * (p & 1); v = w_qidx[(size_t)c * 512 + h * 64 + d]; }
        v *= qnw[c];
        const float o = shdn(v, 1, lane); if ((e & 1) == 0) *(unsigned*)(Wdq + e) = cvt_pk_bf16(v, o);
    }
    { bf16_t* wuvt = (bf16_t*)(ws + WS_WUVT);
      for (int e = gt; e < 8 * 64 * 128; e += NGT) { const int h = e >> 13, v = (e >> 7) & 63, c = e & 127; const float x = w_uv[(size_t)h * 8192 + c * 64 + v];
          const float o = shdn(x, 1, lane); if ((e & 1) == 0) *(unsigned*)(wuvt + e) = cvt_pk_bf16(x, o); } }
    float* tab32 = (float*)(ws + WS_TAB32); float* tab64 = (float*)(ws + WS_TAB64);
    for (int e = gt; e < 2048 * 16; e += NGT) { const int t = e >> 4, i = e & 15; const float inv = powf(10000.f, -(float)(2 * i) / 32.f); float s, c; sincosf((float)t * inv, &s, &c); tab32[2 * e] = c; tab32[2 * e + 1] = s; }
    for (int e = gt; e < 2048 * 32; e += NGT) { const int t = e >> 5, i = e & 31; const float inv = powf(10000.f, -(float)(2 * i) / 64.f); float s, c; sincosf((float)t * inv, &s, &c); tab64[2 * e] = c; tab64[2 * e + 1] = s; }
    if (gt < 512) { const float a0 = in[4][gt], a1 = in[4][512 + gt]; ((float*)(ws + WS_LB))[gt] = 1.f / (1.f + expf(a1 - a0)); }
}

__device__ __forceinline__ void kv_prep_grp(Frame& F, int grp, int lane) {
    uchar* ws = F.ws; const int row0 = grp * 8; const int b = row0 >> 11, t0 = row0 & (SEQ - 1);
    const f32x2 wk = *(const f32x2*)(F.in[7] + 2 * lane);
#pragma unroll
    for (int j = 0; j < 8; ++j) {
        const int row = row0 + j, t = t0 + j; const float* r9 = (const float*)(ws + WS_R9) + (size_t)(row >> 12) * XS_R9 + (size_t)row * 256;
        bf16_t* kv = (bf16_t*)(ws + WS_KV) + (size_t)(row >> 12) * XS_KV + (size_t)row * 160; bf16_t* kidx = (bf16_t*)(ws + WS_KIDX) + (size_t)(row >> 12) * XS_KIDX + (size_t)row * 64;
        const f32x2 a = *(const f32x2*)(r9 + 2 * lane); const float ss = wave_sum(a[0] * a[0] + a[1] * a[1], lane); const float rn = rsqrtf(ss * (1.f / 128.f) + EPS);
        const unsigned pk = cvt_pk_bf16(a[0] * rn * wk[0], a[1] * rn * wk[1]);
        *(unsigned*)(kv + 2 * lane) = pk;
        if (lane < 16) { const float x0 = r9[128 + lane], x1 = r9[144 + lane]; const f32x2 cs = *(const f32x2*)((const float*)(ws + WS_TAB32) + ((size_t)t * 16 + lane) * 2);
            *(unsigned*)(kv + 128 + 2 * lane) = cvt_pk_bf16(x0 * cs[0] - x1 * cs[1], x1 * cs[0] + x0 * cs[1]); }
        { const int i = lane & 31; const float x0 = r9[160 + i], x1 = r9[192 + i]; float s2 = x0 * x0 + x1 * x1;
#pragma unroll
          for (int o = 1; o < 32; o <<= 1) s2 += shx(s2, o, lane);
          const float rk = rsqrtf(s2 * (1.f / 64.f) + EPS); const float y0 = x0 * rk * F.in[8][i], y1 = x1 * rk * F.in[8][32 + i];
          const f32x2 cs = *(const f32x2*)((const float*)(ws + WS_TAB64) + ((size_t)t * 32 + i) * 2);
          if (lane < 32) *(unsigned*)(kidx + 2 * i) = cvt_pk_bf16(y0 * cs[0] - y1 * cs[1], y1 * cs[0] + y0 * cs[1]); }
        if (lane < 8) ((float*)(ws + WS_WIDX))[(size_t)row * 8 + lane] = r9[224 + lane] * 0.044194173824159216f;
    }
}

constexpr int HG_QREF = 0, HG_QT = 16384, HG_KV0 = 32768, HG_KHT = 73728, HG_VT = 90112, HG_AM = 106496, HG_ST = 114688, HG_TOT = 147456, HG_DV = 151552, HG_SS = 152064;
__device__ __forceinline__ int hg_kv_off(int i) { return HG_KV0 + (i == 0 ? 0 : (i == 1 ? 4096 : (i == 2 ? 12288 : 24576))); }
__device__ __forceinline__ void hgrn_chain(Frame& F, int chain) {
    LAS uchar* L = F.lds; uchar* ws = F.ws;
    const int lane = fresh_lane(), tid = F.wave * 64 + lane;
    const int b = chain >> 2, h = chain & 3, w = F.wave, g = lane >> 4, c16 = lane & 15, kp = lane;
    const int ii = w & 3, half = w >> 2, si = w >> 1;
    const float* Gp = (const float*)(ws + WS_G); const bf16_t* HV = (const bf16_t*)(ws + WS_HV); const bf16_t* SG = HV + 512;
    bf16_t* OALL = (bf16_t*)F.out; constexpr int OSTR = 2048;
    const bf16_t* HQ = (const bf16_t*)(ws + WS_HQ) + (size_t)(b >> 1) * XS_HQ; const float* onw = F.in[5] + h * 128;
    for (int o = tid * 16; o < 32768 + 8192; o += NTHR * 16) *(LAS u32x4*)(L + HG_AM + o) = (u32x4){0u, 0u, 0u, 0u};
    f32x4 S[8];
#pragma unroll
    for (int n = 0; n < 8; ++n) S[n] = (f32x4){0.f, 0.f, 0.f, 0.f};
    f32x2 gq[8]; unsigned qv[8], vv[8];
    const size_t rowbase = (size_t)b * SEQ;
#define HG_LOAD(c) do { _Pragma("unroll") for (int j = 0; j < 8; ++j) { const size_t row = rowbase + 64 * (c) + 8 * w + j; \
        gq[j] = *(const f32x2*)(Gp + row * 512 + h * 128 + 2 * kp); qv[j] = *(const unsigned*)(HQ + row * 512 + h * 128 + 2 * kp); vv[j] = *(const unsigned*)(HV + row * 1024 + h * 128 + 2 * kp); } } while (0)
    HG_LOAD(0);
    __syncthreads();
    for (int c = 0; c < 32; ++c) {
        float c0[8], c1[8]; { float s0 = 0.f, s1 = 0.f;
#pragma unroll
            for (int j = 0; j < 8; ++j) { s0 += gq[j][0]; s1 += gq[j][1]; c0[j] = s0; c1[j] = s1; }
            *(LAS f32x2*)(L + HG_TOT + (w * 128 + 2 * kp) * 4) = (f32x2){s0, s1}; }
        __syncthreads();
        f32x2 pre[9]; pre[0] = (f32x2){0.f, 0.f};
#pragma unroll
        for (int k = 0; k < 8; ++k) { const f32x2 t = *(const LAS f32x2*)(L + HG_TOT + (k * 128 + 2 * kp) * 4); pre[k + 1] = pre[k] + t; }
        f32x2 beta = pre[0], pw = pre[0];
#pragma unroll
        for (int k = 1; k < 8; ++k) { if (2 * si == k) beta = pre[k]; if (w == k) pw = pre[k]; }
        const f32x2 off = pw - beta, blast = pre[8];
        const f32x2 eb = (f32x2){fast_exp(beta[0]), fast_exp(beta[1])};
        const f32x2 fl = (f32x2){fast_exp(blast[0] - beta[0]), fast_exp(blast[1] - beta[1])};
        f32x2 fi[4];
#pragma unroll
        for (int i2 = 0; i2 < 4; ++i2) { const f32x2 d = pre[2 * i2] - beta; fi[i2] = (f32x2){fast_exp(fminf(d[0], 0.f)), fast_exp(fminf(d[1], 0.f))}; }
        if (w == 0) *(LAS f32x2*)(L + HG_DV + 2 * kp * 4) = (f32x2){fast_exp(blast[0]), fast_exp(blast[1])};
        unsigned kh0[4], kh1[4], vt0[4], vt1[4];
#pragma unroll
        for (int j = 0; j < 8; ++j) {
            const float cj0 = off[0] + c0[j], cj1 = off[1] + c1[j];
            const float e0 = fast_exp(cj0), e1 = fast_exp(cj1), ei0 = fast_exp(-cj0), ei1 = fast_exp(-cj1);
            const float k0 = (1.f - fast_exp(gq[j][0])) * ei0, k1 = (1.f - fast_exp(gq[j][1])) * ei1;
            const float q0 = bf_lo(qv[j]) * e0, q1 = bf_hi(qv[j]) * e1;
            const int t = 8 * w + j; const int eo = sw256(t, kp >> 2) + (kp & 3) * 4;
            *(LAS unsigned*)(L + HG_QREF + eo) = cvt_pk_bf16(q0, q1);
            *(LAS unsigned*)(L + HG_QT + eo) = cvt_pk_bf16(q0 * eb[0], q1 * eb[1]);
#pragma unroll
            for (int i2 = 0; i2 < 4; ++i2) if (i2 >= si) *(LAS unsigned*)(L + hg_kv_off(i2) + eo) = cvt_pk_bf16(k0 * fi[i2][0], k1 * fi[i2][1]);
            const float h0 = k0 * fl[0], h1 = k1 * fl[1];
            if (j & 1) { kh0[j >> 1] = cvt_pk_bf16(__uint_as_float(kh0[j >> 1]), h0); kh1[j >> 1] = cvt_pk_bf16(__uint_as_float(kh1[j >> 1]), h1);
                         vt0[j >> 1] = (vt0[j >> 1] & 0xffffu) | (vv[j] << 16); vt1[j >> 1] = (vt1[j >> 1] >> 16) | (vv[j] & 0xffff0000u); }
            else { kh0[j >> 1] = __float_as_uint(h0); kh1[j >> 1] = __float_as_uint(h1); vt0[j >> 1] = vv[j] & 0xffffu; vt1[j >> 1] = vv[j] & 0xffff0000u; }
        }
        *(LAS u32x4*)(L + HG_KHT + sw128(2 * kp, w)) = (u32x4){kh0[0], kh0[1], kh0[2], kh0[3]};
        *(LAS u32x4*)(L + HG_KHT + sw128(2 * kp + 1, w)) = (u32x4){kh1[0], kh1[1], kh1[2], kh1[3]};
        *(LAS u32x4*)(L + HG_VT + sw128(2 * kp, w)) = (u32x4){vt0[0], vt0[1], vt0[2], vt0[3]};
        *(LAS u32x4*)(L + HG_VT + sw128(2 * kp + 1, w)) = (u32x4){vt1[0], vt1[1], vt1[2], vt1[3]};
        __syncthreads();
        { const int cn = c + 1 < 32 ? c + 1 : 31; HG_LOAD(cn); }
        const size_t orow = rowbase + 64 * c + 16 * ii + c16;
        u32x2 sgv[4];
#pragma unroll
        for (int n = 0; n < 4; ++n) sgv[n] = *(const u32x2*)(SG + orow * 1024 + h * 128 + 64 * half + 16 * n + 4 * g);
        f32x4 oT[4];
        {
            const int jA = half, jB = half + 2;
            bf16x8 qr[4], kvA[4], kvB[4], qt[4], stf[4][4];
#pragma unroll
            for (int ks = 0; ks < 4; ++ks) { qr[ks] = *(const LAS bf16x8*)(L + HG_QREF + sw256(16 * ii + c16, 4 * ks + g));
                kvA[ks] = *(const LAS bf16x8*)(L + hg_kv_off(ii) + sw256(16 * jA + c16, 4 * ks + g)); kvB[ks] = *(const LAS bf16x8*)(L + hg_kv_off(ii) + sw256(16 * jB + c16, 4 * ks + g));
                qt[ks] = *(const LAS bf16x8*)(L + HG_QT + sw256(16 * ii + c16, 4 * ks + g)); }
            __builtin_amdgcn_sched_barrier(0);
#pragma unroll
            for (int n = 0; n < 2; ++n)
#pragma unroll
                for (int ks = 0; ks < 4; ++ks) stf[n][ks] = *(const LAS bf16x8*)(L + HG_ST + sw256(64 * half + 16 * n + c16, 4 * ks + g));
            f32x4 aA = (f32x4){0.f, 0.f, 0.f, 0.f}, aB = aA;
#pragma unroll
            for (int ks = 0; ks < 4; ++ks) { aA = mma16(kvA[ks], qr[ks], aA); aB = mma16(kvB[ks], qr[ks], aB); }
            __builtin_amdgcn_sched_barrier(0);
#pragma unroll
            for (int n = 2; n < 4; ++n)
#pragma unroll
                for (int ks = 0; ks < 4; ++ks) stf[n][ks] = *(const LAS bf16x8*)(L + HG_ST + sw256(64 * half + 16 * n + c16, 4 * ks + g));
#pragma unroll
            for (int n = 0; n < 2; ++n) { oT[n] = (f32x4){0.f, 0.f, 0.f, 0.f};
#pragma unroll
                for (int ks = 0; ks < 4; ++ks) oT[n] = mma16(stf[n][ks], qt[ks], oT[n]); }
            __builtin_amdgcn_sched_barrier(0);
#pragma unroll
            for (int n = 2; n < 4; ++n) { oT[n] = (f32x4){0.f, 0.f, 0.f, 0.f};
#pragma unroll
                for (int ks = 0; ks < 4; ++ks) oT[n] = mma16(stf[n][ks], qt[ks], oT[n]); }
            if (jA <= ii) { if (jA == ii) {
#pragma unroll
                    for (int r = 0; r < 4; ++r) if (4 * g + r > c16) aA[r] = 0.f; }
                u32x2 pk; pk.x = cvt_pk_bf16(aA[0], aA[1]); pk.y = cvt_pk_bf16(aA[2], aA[3]);
                *(LAS u32x2*)(L + HG_AM + sw128(16 * ii + c16, 2 * jA + (g >> 1)) + (g & 1) * 8) = pk; }
            if (jB <= ii) { if (jB == ii) {
#pragma unroll
                    for (int r = 0; r < 4; ++r) if (4 * g + r > c16) aB[r] = 0.f; }
                u32x2 pk; pk.x = cvt_pk_bf16(aB[0], aB[1]); pk.y = cvt_pk_bf16(aB[2], aB[3]);
                *(LAS u32x2*)(L + HG_AM + sw128(16 * ii + c16, 2 * jB + (g >> 1)) + (g & 1) * 8) = pk; }
        }
        __syncthreads();
        {
            bf16x8 am[2], kh[2], vs[8][2];
#pragma unroll
            for (int ks = 0; ks < 2; ++ks) { am[ks] = *(const LAS bf16x8*)(L + HG_AM + sw128(16 * ii + c16, 4 * ks + g)); kh[ks] = *(const LAS bf16x8*)(L + HG_KHT + sw128(16 * w + c16, 4 * ks + g));
#pragma unroll
                for (int n = 0; n < 8; ++n) vs[n][ks] = *(const LAS bf16x8*)(L + HG_VT + sw128(16 * n + c16, 4 * ks + g)); }
            const f32x4 d4 = *(const LAS f32x4*)(L + HG_DV + (16 * w + 4 * g) * 4);
            __builtin_amdgcn_sched_barrier(0);
#pragma unroll
            for (int ks = 0; ks < 2; ++ks)
#pragma unroll
                for (int n = 0; n < 4; ++n) oT[n] = half ? mma16(vs[4 + n][ks], am[ks], oT[n]) : mma16(vs[n][ks], am[ks], oT[n]);
            { float ss = 0.f;
#pragma unroll
              for (int n = 0; n < 4; ++n) ss += (oT[n][0] * oT[n][0] + oT[n][1] * oT[n][1]) + (oT[n][2] * oT[n][2] + oT[n][3] * oT[n][3]);
              ss += shx(ss, 16, lane); ss += shx(ss, 32, lane);
              if (g == 0) *(LAS float*)(L + HG_SS + (half * 64 + 16 * ii + c16) * 4) = ss; }
#pragma unroll
            for (int n = 0; n < 8; ++n) S[n] = S[n] * d4;
#pragma unroll
            for (int ks = 0; ks < 2; ++ks)
#pragma unroll
                for (int n = 0; n < 8; ++n) S[n] = mma16(kh[ks], vs[n][ks], S[n]);
#pragma unroll
            for (int n = 0; n < 8; ++n) { u32x2 pk; pk.x = cvt_pk_bf16(S[n][0], S[n][1]); pk.y = cvt_pk_bf16(S[n][2], S[n][3]);
                *(LAS u32x2*)(L + HG_ST + sw256(16 * n + c16, 2 * w + (g >> 1)) + (g & 1) * 8) = pk; }
        }
        __syncthreads();
        { const float ss = *(const LAS float*)(L + HG_SS + (16 * ii + c16) * 4) + *(const LAS float*)(L + HG_SS + (64 + 16 * ii + c16) * 4);
          const float rn = rsqrtf(ss * (1.f / 128.f) + EPS);
#pragma unroll
          for (int n = 0; n < 4; ++n) { const int dv0 = 64 * half + 16 * n + 4 * g; const f32x4 wv = *(const f32x4*)(onw + dv0);
              u32x2 pk; pk.x = cvt_pk_bf16(oT[n][0] * rn * wv[0] * bf_lo(sgv[n].x), oT[n][1] * rn * wv[1] * bf_hi(sgv[n].x));
              pk.y = cvt_pk_bf16(oT[n][2] * rn * wv[2] * bf_lo(sgv[n].y), oT[n][3] * rn * wv[3] * bf_hi(sgv[n].y));
              *(u32x2*)(OALL + orow * OSTR + h * 128 + dv0) = pk; } }
    }
#undef HG_LOAD
    __syncthreads();
}

constexpr int KC_STR = 288, KR_STR = 96, VT_STR = 160, PS_STR = 160, QX_STR = 1056;
constexpr int AT_KC = 0, AT_KR = 18432, AT_VT = 24576, AT_BUF = 45056  , AT_PS = 90112, AT_MASK = 131072, AT_EQM = 139520, AT_CNT = 147968;
constexpr int SC_STR = 8208;
constexpr int MK_STR = 66  , HS_STR = 260  ;
template <bool SHARED, bool MASKED>
__device__ __forceinline__ void attn_unit(Frame& F, const bf16_t* qptr, int qstride, bf16_t* optr, int ostride, const bf16_t* qrptr, int qrstride, const bf16_t* kbase, int kstride, const bf16_t* vbase, int vstride, int ntiles, const bf16_t* wuvt = nullptr) {
    constexpr int NKS = SHARED ? 5 : 4;
    const int lane = fresh_lane(), tid = F.wave * 64 + lane;
    LAS uchar* L = F.lds; const int w = F.wave, g = lane >> 4, c16 = lane & 15;
    bf16x8 qf[2][NKS];
#pragma unroll
    for (int mt = 0; mt < 2; ++mt) {
#pragma unroll
        for (int ks = 0; ks < 4; ++ks) qf[mt][ks] = *(const bf16x8*)(qptr + (size_t)(16 * mt + c16) * qstride + 32 * ks + 8 * g);
        if (SHARED) qf[mt][NKS - 1] = *(const bf16x8*)(qrptr + (size_t)(16 * mt + c16) * qrstride + 8 * g);
    }
    constexpr int KNT = SHARED ? 4096 : 16 * KC_STR, KRNT = SHARED ? 1024 : 16 * KR_STR, VCT = SHARED ? 2048 : 16 * VT_STR;
    int kofs[5], vofs[2];
#pragma unroll
    for (int ks = 0; ks < 4; ++ks) kofs[ks] = SHARED ? AT_KC + c16 * 256 + (((4 * ks + g) ^ c16) << 4) : AT_KC + c16 * KC_STR + g * 16 + ks * 64;
    kofs[4] = SHARED ? AT_KR + c16 * 64 + ((g ^ ((0x78 >> (((c16 >> 2) & 3) * 2)) & 3)) << 4) : AT_KR + c16 * KR_STR + g * 16;
#pragma unroll
    for (int hf = 0; hf < 2; ++hf) vofs[hf] = SHARED ? AT_VT + c16 * 128 + (((4 * hf + g) ^ ((c16 >> 1) & 7)) << 4) : AT_VT + c16 * VT_STR + g * 16 + hf * 64;
    LAS uchar* psr = L + AT_PS + w * (32 * PS_STR) + c16 * PS_STR + g * 16; LAS uchar* psw = L + AT_PS + w * (32 * PS_STR) + c16 * PS_STR + g * 8;
    f32x4 O[2][8];
#pragma unroll
    for (int mt = 0; mt < 2; ++mt)
#pragma unroll
        for (int ct = 0; ct < 8; ++ct) O[mt][ct] = (f32x4){0.f, 0.f, 0.f, 0.f};
    float mrow[2] = {-1e30f, -1e30f}, lsum[2] = {0.f, 0.f};
    unsigned dk[2] = {0u, 0u}, dv[2] = {0u, 0u}, dr = 0u;
    if (SHARED) {
#pragma unroll
        for (int q = 0; q < 2; ++q) { const int n = w + 8 * q; const int rk = 4 * n + (lane >> 4), pk = lane & 15; dk[q] = (unsigned)(rk * kstride + 8 * (pk ^ (rk & 15)));
            const int rv = 8 * n + (lane >> 3), pv = lane & 7; dv[q] = (unsigned)(rv * vstride + 8 * (pv ^ ((rv >> 1) & 7))); }
        { const int rr = 16 * (w & 3) + (lane >> 2), pr = lane & 3; dr = (unsigned)(rr * kstride + 128 + 8 * (pr ^ ((0x78 >> (((rr >> 2) & 3) * 2)) & 3))); }
    }
#define AT_DMA(kt, bo) do { _Pragma("unroll") for (int q = 0; q < 2; ++q) { \
        __builtin_amdgcn_global_load_lds((const unsigned*)(kbase + (size_t)(kt) * 64 * kstride + dk[q]), (LAS unsigned*)(L + (bo) + AT_KC + (w + 8 * q) * 1024), 16, 0, 0); \
        __builtin_amdgcn_global_load_lds((const unsigned*)(vbase + (size_t)(kt) * 64 + dv[q]), (LAS unsigned*)(L + (bo) + AT_VT + (w + 8 * q) * 1024), 16, 0, 0); } \
        if (w < 4) __builtin_amdgcn_global_load_lds((const unsigned*)(kbase + (size_t)(kt) * 64 * kstride + dr), (LAS unsigned*)(L + (bo) + AT_KR + w * 1024), 16, 0, 0); } while (0)
    u32x4 st[4]; const bf16_t* gp[4];
    if (!SHARED) {
#pragma unroll
        for (int i = 0; i < 4; ++i) { const int cid = tid + 512 * i; const int key = (cid & 1023) >> 4, ch = cid & 15; gp[i] = (i < 2 ? kbase : vbase) + (size_t)key * (i < 2 ? kstride : vstride) + ch * 8; }
    }
#define AT_FETCH(kt) do { _Pragma("unroll") for (int i = 0; i < 4; ++i) st[i] = *(const u32x4*)(gp[i] + (size_t)(kt) * 64 * (i < 2 ? kstride : vstride)); } while (0)
#define AT_STORE(bo) do { _Pragma("unroll") for (int i = 0; i < 4; ++i) { const int cid = tid + 512 * i; const int key = (cid & 1023) >> 4, ch = cid & 15; \
        if (i < 2) *(LAS u32x4*)(L + (bo) + AT_KC + key * KC_STR + ch * 16) = st[i]; \
        else { const unsigned e4[4] = {st[i].x, st[i].y, st[i].z, st[i].w}; \
            _Pragma("unroll") for (int e = 0; e < 8; ++e) { const int c = 8 * ch + e; *(LAS bf16_t*)(L + (bo) + AT_VT + c * VT_STR + key * 2) = (bf16_t)((e & 1) ? (e4[e >> 1] >> 16) : (e4[e >> 1] & 0xffffu)); } } } } while (0)
    if (!SHARED) AT_FETCH(0);
    __syncthreads();
    if (SHARED) AT_DMA(0, 0); else { AT_STORE(0); if (ntiles > 1) AT_FETCH(1); }
    __syncthreads();
    for (int kt = 0; kt < ntiles; ++kt) {
        const int bo = (kt & 1) * AT_BUF;
        if (kt + 1 < ntiles) { if (SHARED) AT_DMA(kt + 1, AT_BUF - bo); else { AT_STORE(AT_BUF - bo); if (kt + 2 < ntiles) AT_FETCH(kt + 2); } }
#define AT_LDK(dst, nt) do { _Pragma("unroll") for (int ks = 0; ks < 4; ++ks) dst[ks] = *(const LAS bf16x8*)(L + bo + kofs[ks] + (nt) * KNT); \
        if (NKS == 5) dst[NKS - 1] = *(const LAS bf16x8*)(L + bo + kofs[4] + (nt) * KRNT); } while (0)
#define AT_MMK(n, src) do { sT[0][n] = (f32x4){0.f, 0.f, 0.f, 0.f}; sT[1][n] = (f32x4){0.f, 0.f, 0.f, 0.f}; \
        _Pragma("unroll") for (int ks = 0; ks < NKS; ++ks) { sT[0][n] = mma16(src[ks], qf[0][ks], sT[0][n]); sT[1][n] = mma16(src[ks], qf[1][ks], sT[1][n]); } } while (0)
        bf16x8 kA[NKS], kB[NKS];
        AT_LDK(kA, 0); AT_LDK(kB, 1); __builtin_amdgcn_sched_barrier(0);
        u32x2 mw[2] = {(u32x2){0xffffffffu, 0xffffffffu}, (u32x2){0xffffffffu, 0xffffffffu}};
        if (MASKED) { mw[0] = *(const LAS u32x2*)(L + AT_MASK + c16 * (MK_STR * 4) + kt * 8); mw[1] = *(const LAS u32x2*)(L + AT_MASK + (16 + c16) * (MK_STR * 4) + kt * 8); }
#pragma unroll
        for (int hf = 0; hf < 2; ++hf) {
            f32x4 sT[2][2];
            AT_MMK(0, kA); AT_MMK(1, kB);
#pragma unroll
            for (int mt = 0; mt < 2; ++mt) {
                const unsigned mword = hf ? mw[mt].y : mw[mt].x; const unsigned sel[2] = {(mword >> (4 * g)) & 15u, (mword >> (16 + 4 * g)) & 15u};
                float mx = fmaxf(fmaxf(fmaxf(sT[mt][0][0], sT[mt][0][1]), fmaxf(sT[mt][0][2], sT[mt][0][3])), fmaxf(fmaxf(sT[mt][1][0], sT[mt][1][1]), fmaxf(sT[mt][1][2], sT[mt][1][3])));
                if (__any(mx > mrow[mt] + 8.0f)) {
                    mx = fmaxf(mx, shx(mx, 16, lane)); mx = fmaxf(mx, shx(mx, 32, lane));
                    const float mn2 = fmaxf(mrow[mt], mx), alpha = __builtin_amdgcn_exp2f(mrow[mt] - mn2); mrow[mt] = mn2; lsum[mt] *= alpha;
#pragma unroll
                    for (int ct = 0; ct < 8; ++ct) O[mt][ct] = O[mt][ct] * alpha;
                }
                const float mn = mrow[mt]; float ps = 0.f;
#pragma unroll
                for (int n = 0; n < 2; ++n) { f32x4 p;
#pragma unroll
                    for (int r = 0; r < 4; ++r) { const float e = __builtin_amdgcn_exp2f(sT[mt][n][r] - mn);
                        const unsigned m = MASKED ? (unsigned)(((int)(sel[n] << (31 - r))) >> 31) : 0xffffffffu;
                        p[r] = __uint_as_float(__float_as_uint(e) & m); ps += p[r]; }
                    u32x2 pk; pk.x = cvt_pk_bf16(p[0], p[1]); pk.y = cvt_pk_bf16(p[2], p[3]);
                    *(LAS u32x2*)(psw + mt * 16 * PS_STR + (2 * hf + n) * 32) = pk; }
                lsum[mt] += ps;
            }
            LDS_WAIT();
            const bf16x8 p0 = *(const LAS bf16x8*)(psr + hf * 64), p1 = *(const LAS bf16x8*)(psr + 16 * PS_STR + hf * 64);
            bf16x8 vv[8];
#pragma unroll
            for (int ct = 0; ct < 8; ++ct) vv[ct] = *(const LAS bf16x8*)(L + bo + vofs[hf] + ct * VCT);
            if (hf == 0) { AT_LDK(kA, 2); AT_LDK(kB, 3); }
            __builtin_amdgcn_sched_barrier(0);
#pragma unroll
            for (int ct = 0; ct < 8; ++ct) { O[0][ct] = mma16(vv[ct], p0, O[0][ct]); O[1][ct] = mma16(vv[ct], p1, O[1][ct]); }
        }
#undef AT_LDK
#undef AT_MMK
        __syncthreads();
    }
#undef AT_STORE
#undef AT_FETCH
#undef AT_DMA
    float inv[2];
#pragma unroll
    for (int mt = 0; mt < 2; ++mt) { float l = lsum[mt]; l += shx(l, 16, lane); l += shx(l, 32, lane); inv[mt] = 1.f / l; }
    if (wuvt == nullptr) {
#pragma unroll
        for (int mt = 0; mt < 2; ++mt)
#pragma unroll
            for (int ct = 0; ct < 8; ++ct) { u32x2 pk; pk.x = cvt_pk_bf16(O[mt][ct][0] * inv[mt], O[mt][ct][1] * inv[mt]); pk.y = cvt_pk_bf16(O[mt][ct][2] * inv[mt], O[mt][ct][3] * inv[mt]);
                *(u32x2*)(optr + (size_t)(16 * mt + c16) * ostride + 16 * ct + 4 * g) = pk; }
    } else {
        f32x4 ob[2][4];
#pragma unroll
        for (int mt = 0; mt < 2; ++mt)
#pragma unroll
            for (int vt = 0; vt < 4; ++vt) ob[mt][vt] = (f32x4){0.f, 0.f, 0.f, 0.f};
#pragma unroll
        for (int sk = 0; sk < 4; ++sk) {
            bf16x8 bq[2];
#pragma unroll
            for (int mt = 0; mt < 2; ++mt) { const unsigned x0 = cvt_pk_bf16(O[mt][2 * sk][0] * inv[mt], O[mt][2 * sk][1] * inv[mt]), x1 = cvt_pk_bf16(O[mt][2 * sk][2] * inv[mt], O[mt][2 * sk][3] * inv[mt]);
                const unsigned x2 = cvt_pk_bf16(O[mt][2 * sk + 1][0] * inv[mt], O[mt][2 * sk + 1][1] * inv[mt]), x3 = cvt_pk_bf16(O[mt][2 * sk + 1][2] * inv[mt], O[mt][2 * sk + 1][3] * inv[mt]);
                bq[mt] = __builtin_bit_cast(bf16x8, (u32x4){x0, x1, x2, x3}); }
#pragma unroll
            for (int vt = 0; vt < 4; ++vt) { const bf16_t* wp = wuvt + (size_t)(16 * vt + c16) * 128 + 32 * sk + 4 * g;
                const u32x2 a0 = *(const u32x2*)wp, a1 = *(const u32x2*)(wp + 16); const bf16x8 af = __builtin_bit_cast(bf16x8, (u32x4){a0.x, a0.y, a1.x, a1.y});
                ob[0][vt] = mma16(af, bq[0], ob[0][vt]); ob[1][vt] = mma16(af, bq[1], ob[1][vt]); }
        }
#pragma unroll
        for (int mt = 0; mt < 2; ++mt)
#pragma unroll
            for (int vt = 0; vt < 4; ++vt) { u32x2 pk; pk.x = cvt_pk_bf16(ob[mt][vt][0], ob[mt][vt][1]); pk.y = cvt_pk_bf16(ob[mt][vt][2], ob[mt][vt][3]);
                *(u32x2*)(optr + (size_t)(16 * mt + c16) * ostride + 16 * vt + 4 * g) = pk; }
    }
}

typedef float f32x16 __attribute__((ext_vector_type(16)));
typedef short s16x4 __attribute__((ext_vector_type(4)));
constexpr int DA_EM = 90112, DA_EMSTR = 272, DA_EMB = 32 * DA_EMSTR;
constexpr int DA_SLOT = 20480;
#define DA_SBAR() __builtin_amdgcn_sched_barrier(0)
#define DA_PIN(x) asm volatile("" : "+v"(x))
#define DA_WAIT_BAR() asm volatile("s_waitcnt vmcnt(0) lgkmcnt(0)\n\ts_barrier" ::: "memory")
__device__ __forceinline__ f32x16 mma32(bf16x8 rowop, bf16x8 colop, f32x16 c) { return __builtin_amdgcn_mfma_f32_32x32x16_bf16(rowop, colop, c, 0, 0, 0); }
__device__ __forceinline__ s16x4 da_vtr(const LAS uchar* p) { return __builtin_bit_cast(s16x4, __builtin_amdgcn_ds_read_tr16_b64_v4i16((LAS s16x4*)p)); }
__device__ __forceinline__ float da_swapmax(float v) { const auto rr = __builtin_amdgcn_permlane32_swap(__float_as_uint(v), __float_as_uint(v), false, false); return fmaxf(__uint_as_float(rr[0]), __uint_as_float(rr[1])); }
__device__ __forceinline__ float da_swapadd(float v) { const auto rr = __builtin_amdgcn_permlane32_swap(__float_as_uint(v), __float_as_uint(v), false, false); return __uint_as_float(rr[0]) + __uint_as_float(rr[1]); }
__device__ __forceinline__ void da_glds16(const void* g, unsigned lds_base) {
    unsigned sv; asm volatile("s_mov_b32 %0, m0\n\ts_mov_b32 m0, %2\n\ts_nop 0\n\tglobal_load_lds_dwordx4 %1, off\n\ts_mov_b32 m0, %0" : "=&s"(sv) : "v"(g), "s"(lds_base) : "memory"); }
__device__ __forceinline__ float da_rowmax(const f32x16& p0, const f32x16& p1) {
    float a = fmaxf(fmaxf(p0[0], p0[1]), p1[0]), b = fmaxf(fmaxf(p0[2], p0[3]), p1[1]); a = fmaxf(fmaxf(a, p1[2]), p1[3]);
#pragma unroll
    for (int r = 4; r < 16; r += 4) { a = fmaxf(fmaxf(a, p0[r]), p0[r + 1]); b = fmaxf(fmaxf(b, p0[r + 2]), p0[r + 3]); a = fmaxf(fmaxf(a, p1[r]), p1[r + 1]); b = fmaxf(fmaxf(b, p1[r + 2]), p1[r + 3]); }
    return da_swapmax(fmaxf(a, b)); }
__device__ __forceinline__ void dsa_ties(Frame& F);
__device__ __forceinline__ void dsa_attn(Frame& F, const bf16_t* qptr, const bf16_t* qrptr, bf16_t* optr, const bf16_t* kvbase, int ntiles, const bf16_t* wuvt) {
    const int lane = fresh_lane(); LAS uchar* L = F.lds; const int w = F.wave, r32 = lane & 31, hi = lane >> 5;
    const unsigned lds0 = (unsigned)(uintptr_t)L;
    const bf16_t* dsrc = kvbase + ((16 * (w & 3) + (lane >> 2)) * 160 + 8 * ((lane & 3) ^ ((lane >> 4) & 3)) + 32 * (w >> 2));
#define DA_DMA(kt, so) do { const bf16_t* s_ = dsrc + (size_t)(kt) * (64 * 160); const unsigned d_ = (unsigned)__builtin_amdgcn_readfirstlane((int)(lds0 + (so) + w * 1024)); \
        da_glds16(s_, d_); da_glds16(s_ + 64, d_ + 8192); if (w < 4) da_glds16(s_ + 128, d_ + 16384); } while (0)
    asm volatile("s_waitcnt lgkmcnt(0)\n\ts_barrier" ::: "memory");
    DA_DMA(0, 0); DA_DMA(1, DA_SLOT);
    bf16x8 qr[10];
#pragma unroll
    for (int d0 = 0; d0 < 8; ++d0) qr[d0] = *(const bf16x8*)(qptr + (size_t)r32 * 2048 + 16 * d0 + 8 * hi);
#pragma unroll
    for (int d0 = 8; d0 < 10; ++d0) qr[d0] = *(const bf16x8*)(qrptr + (size_t)r32 * 256 + 16 * (d0 - 8) + 8 * hi);
    const int fz = (r32 >> 2) & 3, kb0 = r32 * 64 + ((hi ^ fz) << 4), kb1 = kb0 ^ 32;
    const int vb0 = (4 * hi + ((lane & 15) >> 2)) * 64 + (((2 * ((lane >> 4) & 1) + ((lane & 3) >> 1)) ^ hi) << 4) + (lane & 1) * 8, vb1 = (vb0 ^ 32) + 512;
    const LAS uchar* emrd = L + DA_EM + r32 * DA_EMSTR + hi * 16;
#define DA_EMPROD(t) do { int pl_ = lane; asm volatile("" : "+v"(pl_)); const int pr_ = 4 * w + (pl_ >> 4), pk_ = pl_ & 15; \
        const int s_ = (int)(*(const LAS unsigned*)(L + AT_MASK + pr_ * (MK_STR * 4) + (pk_ >> 3) * 4 + (t) * 8) >> (4 * (pk_ & 7))); \
        *(LAS u32x4*)(L + DA_EM + pr_ * DA_EMSTR + pk_ * 16 + ((t) & 1) * DA_EMB) = (u32x4){(unsigned)__builtin_amdgcn_sbfe(s_, 0, 1), (unsigned)__builtin_amdgcn_sbfe(s_, 1, 1), (unsigned)__builtin_amdgcn_sbfe(s_, 2, 1), (unsigned)__builtin_amdgcn_sbfe(s_, 3, 1)}; } while (0)
#define DA_MRD(base, c) do { mr[(c) & 1] = *(const LAS u32x4*)((base) + ((c) >> 2) * 128 + ((c) & 3) * 32); } while (0)
    float m_reg, l_reg = 0.f, alpha = 1.f; bool resc = false;
    f32x16 o[4], pA0, pA1, pB0, pB1; u32x4 mr[2]; u32x4 pw0, pw1, pw2, pw3; bf16x8 kf[20]; s16x4 vlo[3], vhi[3];
    const f32x16 zero16 = {0.f, 0.f, 0.f, 0.f, 0.f, 0.f, 0.f, 0.f, 0.f, 0.f, 0.f, 0.f, 0.f, 0.f, 0.f, 0.f};
#pragma unroll
    for (int db = 0; db < 4; ++db) o[db] = zero16;
#define DA_KRD(base, d0) do { const LAS uchar* kp_ = (base) + (((d0) & 1) ? kb1 : kb0) + ((d0) >> 1) * 4096; kf[2 * (d0)] = *(const LAS bf16x8*)kp_; kf[2 * (d0) + 1] = *(const LAS bf16x8*)(kp_ + 2048); } while (0)
#define DA_VRD(base, i) do { vlo[(i) % 3] = da_vtr((base) + vb0 + ((i) >> 2) * 4096 + ((i) & 3) * 1024); vhi[(i) % 3] = da_vtr((base) + vb1 + ((i) >> 2) * 4096 + ((i) & 3) * 1024); } while (0)
#define DA_VF(i) (bf16x8){vlo[(i) % 3][0], vlo[(i) % 3][1], vlo[(i) % 3][2], vlo[(i) % 3][3], vhi[(i) % 3][0], vhi[(i) % 3][1], vhi[(i) % 3][2], vhi[(i) % 3][3]}
#define DA_PAF(k) __builtin_bit_cast(bf16x8, pw##k)
#define DA_BITPOS(r) (((r) & 3) + 8 * ((r) >> 2))
#define DA_FIN(P, r, c, e, PW, k) do { const float x0_ = __uint_as_float(__float_as_uint(P[r]) & mr[(c) & 1][e]), x1_ = __uint_as_float(__float_as_uint(P[(r) + 1]) & mr[(c) & 1][(e) + 1]); \
        sacc += x0_; sacc += x1_; PW[k] = cvt_pk_bf16(x0_, x1_); DA_PIN(PW); DA_PIN(sacc); } while (0)
#define DA_GAP(MFX, FILL) do { MFX; FILL; DA_SBAR(); } while (0)
#define DA_EX2(X, i) do { X[i] = __builtin_amdgcn_exp2f(X[i] + nm); X[(i) + 1] = __builtin_amdgcn_exp2f(X[(i) + 1] + nm); DA_PIN(X); } while (0)
#define DA_RESC() do { if (resc) { _Pragma("unroll") for (int db = 0; db < 4; ++db) _Pragma("unroll") for (int r = 0; r < 16; ++r) o[db][r] *= alpha; } } while (0)
    int slp = 0, slc = DA_SLOT, sln = 2 * DA_SLOT, sl2 = 3 * DA_SLOT;
#define DA_ROT() do { const int t_ = slp; slp = slc; slc = sln; sln = sl2; sl2 = t_; } while (0)
    dsa_ties(F);
    DA_WAIT_BAR();
    DA_DMA(2, 2 * DA_SLOT);
#pragma unroll
    for (int d0 = 0; d0 < 10; ++d0) DA_KRD(L, d0);
    pA0 = mma32(kf[0], qr[0], zero16); pA1 = mma32(kf[1], qr[0], zero16);
#pragma unroll
    for (int d0 = 1; d0 < 10; ++d0) { pA0 = mma32(kf[2 * d0], qr[d0], pA0); pA1 = mma32(kf[2 * d0 + 1], qr[d0], pA1); }
    m_reg = da_rowmax(pA0, pA1);
    { const float nm = -m_reg;
#pragma unroll
      for (int r = 0; r < 16; r += 2) { DA_EX2(pA0, r); DA_EX2(pA1, r); } }
    DA_EMPROD(0);
    DA_KRD(L + DA_SLOT, 0);
    DA_WAIT_BAR();
#define DA_STEP(C0, C1, P0, P1, t) do { DA_SBAR(); \
    { const LAS uchar* kc_ = L + slc; const LAS uchar* vp_ = L + slp; const LAS uchar* kn_ = L + sln; \
    { const int tn_ = (t) + 2 < 32 ? (t) + 2 : 31; DA_DMA(tn_, sl2); }                         \
    const LAS uchar* em_ = emrd + (((t) - 1) & 1) * DA_EMB; float sacc = 0.f; \
    DA_MRD(em_, 0); DA_MRD(em_, 1); DA_KRD(kc_, 1); DA_SBAR(); DA_GAP(C0 = mma32(kf[0], qr[0], zero16), (void)0); DA_GAP(C1 = mma32(kf[1], qr[0], zero16), (void)0); \
    DA_KRD(kc_, 2); DA_SBAR(); DA_GAP(C0 = mma32(kf[2], qr[1], C0), DA_FIN(P0, 0, 0, 0, pw0, 0)); DA_GAP(C1 = mma32(kf[3], qr[1], C1), DA_FIN(P0, 2, 0, 2, pw0, 1)); \
    DA_MRD(em_, 2); DA_KRD(kc_, 3); DA_SBAR(); DA_GAP(C0 = mma32(kf[4], qr[2], C0), DA_FIN(P0, 4, 1, 0, pw0, 2)); DA_GAP(C1 = mma32(kf[5], qr[2], C1), DA_FIN(P0, 6, 1, 2, pw0, 3)); \
    DA_MRD(em_, 3); DA_KRD(kc_, 4); DA_SBAR(); DA_GAP(C0 = mma32(kf[6], qr[3], C0), DA_FIN(P0, 8, 2, 0, pw1, 0)); DA_GAP(C1 = mma32(kf[7], qr[3], C1), DA_FIN(P0, 10, 2, 2, pw1, 1)); \
    DA_MRD(em_, 4); DA_KRD(kc_, 5); DA_SBAR(); DA_GAP(C0 = mma32(kf[8], qr[4], C0), DA_FIN(P0, 12, 3, 0, pw1, 2)); DA_GAP(C1 = mma32(kf[9], qr[4], C1), DA_FIN(P0, 14, 3, 2, pw1, 3)); \
    DA_MRD(em_, 5); DA_KRD(kc_, 6); DA_SBAR(); DA_GAP(C0 = mma32(kf[10], qr[5], C0), DA_FIN(P1, 0, 4, 0, pw2, 0)); DA_GAP(C1 = mma32(kf[11], qr[5], C1), DA_FIN(P1, 2, 4, 2, pw2, 1)); \
    DA_MRD(em_, 6); DA_KRD(kc_, 7); DA_SBAR(); DA_GAP(C0 = mma32(kf[12], qr[6], C0), DA_FIN(P1, 4, 5, 0, pw2, 2)); DA_GAP(C1 = mma32(kf[13], qr[6], C1), DA_FIN(P1, 6, 5, 2, pw2, 3)); \
    DA_MRD(em_, 7); DA_KRD(kc_, 8); DA_SBAR(); DA_GAP(C0 = mma32(kf[14], qr[7], C0), DA_FIN(P1, 8, 6, 0, pw3, 0)); DA_GAP(C1 = mma32(kf[15], qr[7], C1), DA_FIN(P1, 10, 6, 2, pw3, 1)); \
    DA_KRD(kc_, 9); DA_VRD(vp_, 0); DA_SBAR(); DA_GAP(C0 = mma32(kf[16], qr[8], C0), DA_FIN(P1, 12, 7, 0, pw3, 2)); DA_GAP(C1 = mma32(kf[17], qr[8], C1), DA_FIN(P1, 14, 7, 2, pw3, 3)); \
    DA_VRD(vp_, 1); DA_SBAR(); DA_GAP(C0 = mma32(kf[18], qr[9], C0), (void)0);                         DA_GAP(C1 = mma32(kf[19], qr[9], C1), (void)0); \
    l_reg += sacc; resc = false; \
    { const float rm = da_rowmax(C0, C1) - m_reg;                                                       \
      if (__builtin_expect(__any(rm > 8.0f), 0)) { const float dl = fmaxf(rm, 0.f); m_reg += dl; alpha = __builtin_amdgcn_exp2f(-dl); l_reg *= alpha; resc = true; } } \
    const float nm = -m_reg; DA_SBAR(); \
    DA_VRD(vp_, 2); DA_SBAR(); DA_GAP(o[0] = mma32(DA_VF(0), DA_PAF(0), o[0]), DA_EX2(C0, 0)); \
    DA_VRD(vp_, 3); DA_SBAR(); DA_GAP(o[0] = mma32(DA_VF(1), DA_PAF(1), o[0]), DA_EX2(C0, 2)); \
    DA_VRD(vp_, 4); DA_SBAR(); DA_GAP(o[0] = mma32(DA_VF(2), DA_PAF(2), o[0]), DA_EX2(C0, 4)); \
    DA_VRD(vp_, 5); DA_SBAR(); DA_GAP(o[0] = mma32(DA_VF(3), DA_PAF(3), o[0]), DA_EX2(C0, 6)); \
    DA_VRD(vp_, 6); DA_SBAR(); DA_GAP(o[1] = mma32(DA_VF(4), DA_PAF(0), o[1]), DA_EX2(C0, 8)); \
    DA_VRD(vp_, 7); DA_SBAR(); DA_GAP(o[1] = mma32(DA_VF(5), DA_PAF(1), o[1]), DA_EX2(C0, 10)); \
    DA_VRD(vp_, 8); DA_SBAR(); DA_GAP(o[1] = mma32(DA_VF(6), DA_PAF(2), o[1]), DA_EX2(C0, 12)); \
    DA_VRD(vp_, 9); DA_SBAR(); DA_GAP(o[1] = mma32(DA_VF(7), DA_PAF(3), o[1]), DA_EX2(C0, 14)); \
    DA_VRD(vp_, 10); DA_SBAR(); DA_GAP(o[2] = mma32(DA_VF(8), DA_PAF(0), o[2]), DA_EX2(C1, 0)); \
    DA_VRD(vp_, 11); DA_SBAR(); DA_GAP(o[2] = mma32(DA_VF(9), DA_PAF(1), o[2]), DA_EX2(C1, 2)); \
    DA_VRD(vp_, 12); DA_SBAR(); DA_GAP(o[2] = mma32(DA_VF(10), DA_PAF(2), o[2]), DA_EX2(C1, 4)); \
    DA_VRD(vp_, 13); DA_KRD(kn_, 0); DA_SBAR(); DA_GAP(o[2] = mma32(DA_VF(11), DA_PAF(3), o[2]), DA_EX2(C1, 6)); \
    DA_VRD(vp_, 14); DA_SBAR(); DA_GAP(o[3] = mma32(DA_VF(12), DA_PAF(0), o[3]), DA_EX2(C1, 8)); \
    DA_VRD(vp_, 15); DA_SBAR(); DA_GAP(o[3] = mma32(DA_VF(13), DA_PAF(1), o[3]), DA_EX2(C1, 10)); \
    DA_SBAR(); DA_GAP(o[3] = mma32(DA_VF(14), DA_PAF(2), o[3]), DA_EX2(C1, 12)); \
    DA_EMPROD(t); DA_SBAR(); DA_GAP(o[3] = mma32(DA_VF(15), DA_PAF(3), o[3]), DA_EX2(C1, 14)); \
    } DA_WAIT_BAR(); DA_RESC(); DA_ROT(); } while (0)
    for (int t = 1; t < ntiles; t += 2) { DA_STEP(pB0, pB1, pA0, pA1, t); DA_STEP(pA0, pA1, pB0, pB1, t + 1); }
#define DA_DRAIN(P0, P1, tl) do { const LAS uchar* em_ = emrd + ((tl) & 1) * DA_EMB; float sacc = 0.f; \
    DA_MRD(em_, 0); DA_MRD(em_, 1); DA_FIN(P0, 0, 0, 0, pw0, 0); DA_FIN(P0, 2, 0, 2, pw0, 1); DA_FIN(P0, 4, 1, 0, pw0, 2); DA_FIN(P0, 6, 1, 2, pw0, 3); \
    DA_MRD(em_, 2); DA_MRD(em_, 3); DA_FIN(P0, 8, 2, 0, pw1, 0); DA_FIN(P0, 10, 2, 2, pw1, 1); DA_FIN(P0, 12, 3, 0, pw1, 2); DA_FIN(P0, 14, 3, 2, pw1, 3); \
    DA_MRD(em_, 4); DA_MRD(em_, 5); DA_FIN(P1, 0, 4, 0, pw2, 0); DA_FIN(P1, 2, 4, 2, pw2, 1); DA_FIN(P1, 4, 5, 0, pw2, 2); DA_FIN(P1, 6, 5, 2, pw2, 3); \
    DA_MRD(em_, 6); DA_MRD(em_, 7); DA_FIN(P1, 8, 6, 0, pw3, 0); DA_FIN(P1, 10, 6, 2, pw3, 1); DA_FIN(P1, 12, 7, 0, pw3, 2); DA_FIN(P1, 14, 7, 2, pw3, 3); \
    l_reg += sacc; const LAS uchar* vp_ = L + slp; \
    _Pragma("unroll") for (int i = 0; i < 16; ++i) { DA_VRD(vp_, i); o[i >> 2] = mma32(DA_VF(i), (i & 3) == 0 ? DA_PAF(0) : ((i & 3) == 1 ? DA_PAF(1) : ((i & 3) == 2 ? DA_PAF(2) : DA_PAF(3))), o[i >> 2]); } } while (0)
    DA_DRAIN(pA0, pA1, 0);
#undef DA_DRAIN
#undef DA_STEP
#undef DA_ROT
#undef DA_RESC
#undef DA_EX2
#undef DA_GAP
#undef DA_FIN
#undef DA_MRD
#undef DA_EMPROD
#undef DA_BITPOS
#undef DA_PAF
#undef DA_VF
#undef DA_VRD
#undef DA_KRD
#undef DA_DMA
    const int lane_e = fresh_lane(), r32e = lane_e & 31, hie = lane_e >> 5;
    const float inv = 1.f / da_swapadd(l_reg);
    f32x16 ob[2]; ob[0] = zero16; ob[1] = zero16;
#pragma unroll
    for (int db = 0; db < 4; ++db)
#pragma unroll
        for (int s = 0; s < 2; ++s) {
            const bf16x8 bq = __builtin_bit_cast(bf16x8, (u32x4){cvt_pk_bf16(o[db][8 * s] * inv, o[db][8 * s + 1] * inv), cvt_pk_bf16(o[db][8 * s + 2] * inv, o[db][8 * s + 3] * inv),
                                                                 cvt_pk_bf16(o[db][8 * s + 4] * inv, o[db][8 * s + 5] * inv), cvt_pk_bf16(o[db][8 * s + 6] * inv, o[db][8 * s + 7] * inv)});
#pragma unroll
            for (int mb = 0; mb < 2; ++mb) { const bf16_t* wp = wuvt + (size_t)(32 * mb + r32e) * 128 + 32 * db + 16 * s + 4 * hie;
                const u32x2 a0 = *(const u32x2*)wp, a1 = *(const u32x2*)(wp + 8);
                ob[mb] = mma32(__builtin_bit_cast(bf16x8, (u32x4){a0.x, a0.y, a1.x, a1.y}), bq, ob[mb]); } }
#pragma unroll
    for (int mb = 0; mb < 2; ++mb)
#pragma unroll
        for (int rg = 0; rg < 4; ++rg) { u32x2 pk; pk.x = cvt_pk_bf16(ob[mb][4 * rg], ob[mb][4 * rg + 1]); pk.y = cvt_pk_bf16(ob[mb][4 * rg + 2], ob[mb][4 * rg + 3]);
            *(u32x2*)(optr + (size_t)r32e * 2048 + 32 * mb + 8 * rg + 4 * hie) = pk; }
}

__device__ __forceinline__ unsigned f2sortable(float x) { const unsigned u = __float_as_uint(x); return (u & 0x80000000u) ? ~u : (u | 0x80000000u); }
constexpr int IX_SC = 0, IX_H = AT_CNT + 512, IX_HSTR = 132  , IX_LST = IX_H + 16 * IX_HSTR * 4, IX_LCAP = 64;
static_assert(IX_LST + 16 * IX_LCAP * 4 <= MISC_OFF, "indexer LDS layout");
struct IxPre { bf16x8 qf[8][2]; float w8[8]; bf16x8 ka0, ka1, kb0, kb1; };
__device__ __forceinline__ void ix_prefetch(Frame& F, int b, int t0, IxPre& P) {
    const int lane = fresh_lane(); uchar* ws = F.ws; const int w = F.wave, g = lane >> 4, c16 = lane & 15;
    const size_t rowq = (size_t)b * SEQ + t0 + c16; const int tmax = t0 + 15;
    const bf16_t* KI = (const bf16_t*)(ws + WS_KIDX) + (size_t)(b >> 1) * XS_KIDX + (size_t)b * SEQ * 64;
    const bf16_t* QI = (const bf16_t*)(ws + WS_QI) + (size_t)(b >> 1) * XS_QI + rowq * 512 + 8 * g;
    const int ntl = tmax / 16 + 1; const int njw = (ntl > w) ? (ntl - w + 7) / 8 : 0; const int jmax = njw > 0 ? njw - 1 : 0;
#pragma unroll
    for (int hh = 0; hh < 8; ++hh) { P.qf[hh][0] = *(const bf16x8*)(QI + hh * 64); P.qf[hh][1] = *(const bf16x8*)(QI + hh * 64 + 32); }
    const f32x4 wA = *(const f32x4*)((const float*)(ws + WS_WIDX) + rowq * 8), wB = *(const f32x4*)((const float*)(ws + WS_WIDX) + rowq * 8 + 4);
    P.w8[0] = wA[0]; P.w8[1] = wA[1]; P.w8[2] = wA[2]; P.w8[3] = wA[3]; P.w8[4] = wB[0]; P.w8[5] = wB[1]; P.w8[6] = wB[2]; P.w8[7] = wB[3];
    const bf16_t* kp = KI + (size_t)(16 * w + c16) * 64 + 8 * g;
    P.ka0 = *(const bf16x8*)kp; P.ka1 = *(const bf16x8*)(kp + 32);
    P.kb0 = *(const bf16x8*)(kp + (size_t)(jmax > 0 ? 1 : 0) * 8192); P.kb1 = *(const bf16x8*)(kp + (size_t)(jmax > 0 ? 1 : 0) * 8192 + 32);
}
__device__ __forceinline__ void ix_score(Frame& F, int b, int t0, IxPre& P) {
    const int lane = fresh_lane(), tid = F.wave * 64 + lane;
    LAS uchar* L = F.lds; uchar* ws = F.ws; const int w = F.wave, g = lane >> 4, c16 = lane & 15;
    const int tq = t0 + c16, tmax = t0 + 15;
    const bf16_t* KI = (const bf16_t*)(ws + WS_KIDX) + (size_t)(b >> 1) * XS_KIDX + (size_t)b * SEQ * 64;
    const int ntl = tmax / 16 + 1;
    const int njw = (ntl > w) ? (ntl - w + 7) / 8 : 0;
    LAS u32x4* SC = (LAS u32x4*)(L + IX_SC) + tid;
    const bf16_t* kp = KI + (size_t)(16 * w + c16) * 64 + 8 * g;
    const int jmax = njw > 0 ? njw - 1 : 0;
#define IX_MMA(dst, k0_, k1_) do { _Pragma("unroll") for (int hh = 0; hh < 8; ++hh) { dst[hh] = mma16(k0_, P.qf[hh][0], (f32x4){0.f, 0.f, 0.f, 0.f}); dst[hh] = mma16(k1_, P.qf[hh][1], dst[hh]); } } while (0)
#define IX_SUM(src, jj) do { f32x4 sc = (f32x4){0.f, 0.f, 0.f, 0.f}; \
        _Pragma("unroll") for (int hh = 0; hh < 8; ++hh) { _Pragma("unroll") for (int r = 0; r < 4; ++r) { const int bi = __float_as_int(src[hh][r]); sc[r] += P.w8[hh] * __int_as_float(bi > 0 ? bi : 0); } } \
        const int kt_ = 16 * (8 * (jj) + w); u32x4 uv; \
        if (kt_ + 15 <= t0) { _Pragma("unroll") for (int r = 0; r < 4; ++r) uv[r] = f2sortable(sc[r]); }                      \
        else { _Pragma("unroll") for (int r = 0; r < 4; ++r) uv[r] = (kt_ + 4 * g + r <= tq) ? f2sortable(sc[r]) : 0u; } \
        SC[512 * (jj)] = uv; } while (0)
#pragma unroll 1
    for (int j = 0; j < njw; j += 2) {
        f32x4 accA[8], accB[8];
        IX_MMA(accA, P.ka0, P.ka1); IX_MMA(accB, P.kb0, P.kb1);
        __builtin_amdgcn_sched_barrier(0);
        { const int j2 = j + 2 < jmax ? j + 2 : jmax, j3 = j + 3 < jmax ? j + 3 : jmax;
          P.ka0 = *(const bf16x8*)(kp + (size_t)j2 * 8192); P.ka1 = *(const bf16x8*)(kp + (size_t)j2 * 8192 + 32); P.kb0 = *(const bf16x8*)(kp + (size_t)j3 * 8192); P.kb1 = *(const bf16x8*)(kp + (size_t)j3 * 8192 + 32); }
        __builtin_amdgcn_sched_barrier(0);
        IX_SUM(accA, j); IX_SUM(accB, j + 1);
    }
#undef IX_MMA
#undef IX_SUM
}
#define IX_LBAR() asm volatile("s_waitcnt lgkmcnt(0)\n\ts_barrier" ::: "memory")
__device__ __forceinline__ void ix_select(Frame& F, int t0, int mrow0) {
    const int lane = fresh_lane(), tid = F.wave * 64 + lane;
    LAS uchar* L = F.lds; const int w = F.wave, g = lane >> 4, c16 = lane & 15;
    const int tmax = t0 + 15;
    const int ntl = tmax / 16 + 1;
    const int njw = (ntl > w) ? (ntl - w + 7) / 8 : 0;
    LAS u32x4* SC = (LAS u32x4*)(L + IX_SC) + tid;
    unsigned T = 1u;
    if (tmax >= 256) {
        LAS unsigned* H = (LAS unsigned*)(L + IX_H); LAS unsigned* SELB = (LAS unsigned*)(L + AT_CNT) + (mrow0 ? 64 : 0); LAS unsigned* LCN = SELB + 32; LAS unsigned* LST = (LAS unsigned*)(L + IX_LST);
        if (tid < 16) { unsigned z0 = 0u, k256 = 256u; asm volatile("" : "+v"(z0), "+v"(k256)); SELB[2 * tid] = z0; SELB[2 * tid + 1] = k256; }
        if (tid < 17) LCN[tid] = 0u;
        unsigned prefix = 0u;
        const int l5 = lane & 31, tokw = 2 * w + (lane >> 5);
#define IX_PASS(p) do { const int shift = 24 - 8 * (p); \
        _Pragma("unroll 2") for (int j = 0; j < njw; ++j) { const u32x4 u4 = SC[512 * j]; \
            _Pragma("unroll") for (int r = 0; r < 4; ++r) { const unsigned u = u4[r]; const bool m = (p) > 0 ? (u != 0u && (u >> (shift + 8)) == prefix) : true;     const unsigned bin = (u >> shift) & 255u; \
                __hip_atomic_fetch_add(&H[c16 * IX_HSTR + (m ? (bin >> 1) : 128u + r)], 1u << (16 * (bin & 1u)), __ATOMIC_RELAXED, __HIP_MEMORY_SCOPE_WORKGROUP); } } \
        IX_LBAR(); \
        { LAS u32x4* hp = (LAS u32x4*)(H + tokw * IX_HSTR + 4 * l5); const u32x4 hw = *hp; *hp = (u32x4){0u, 0u, 0u, 0u};           \
          const unsigned c[8] = {hw.x & 0xffffu, hw.x >> 16, hw.y & 0xffffu, hw.y >> 16, hw.z & 0xffffu, hw.z >> 16, hw.w & 0xffffu, hw.w >> 16}; \
          const unsigned sl = ((c[0] + c[1]) + (c[2] + c[3])) + ((c[4] + c[5]) + (c[6] + c[7])); unsigned suf = sl; \
          _Pragma("unroll") for (int o = 1; o < 32; o <<= 1) { const unsigned t = (unsigned)__builtin_amdgcn_ds_bpermute((l5 + o < 32 ? lane + o : lane) << 2, (int)suf); if (l5 + o < 32) suf += t; } \
          const unsigned kr = SELB[2 * tokw + 1], excl = suf - sl; LDS_WAIT(); \
          if (excl < kr && kr <= suf) { unsigned above = excl, bin = 0u; bool found = false; \
              _Pragma("unroll") for (int q = 7; q >= 0; --q) { if (!found) { if (above + c[q] >= kr) { bin = (unsigned)q; found = true; } else above += c[q]; } } \
              SELB[2 * tokw] = 8u * l5 + bin; SELB[2 * tokw + 1] = kr - above; } } \
        IX_LBAR(); \
        prefix = (prefix << 8) | SELB[2 * c16]; } while (0)
        IX_PASS(0); IX_PASS(1);
#pragma unroll 2
        for (int j = 0; j < njw; ++j) { const u32x4 u4 = SC[512 * j];
#pragma unroll
            for (int r = 0; r < 4; ++r) { const unsigned u = u4[r];
                if (u != 0u && (u >> 16) == prefix) { const unsigned pos = __hip_atomic_fetch_add(&LCN[c16], 1u, __ATOMIC_RELAXED, __HIP_MEMORY_SCOPE_WORKGROUP);
                    if (pos < (unsigned)IX_LCAP) LST[c16 * IX_LCAP + pos] = u; else LCN[16] = 1u; } } }
        IX_LBAR();
        if (__builtin_amdgcn_readfirstlane(LCN[16]) == 0u) {
            const unsigned lenA = __builtin_amdgcn_readfirstlane(LCN[2 * w]), lenB = __builtin_amdgcn_readfirstlane(LCN[2 * w + 1]);
            if (lenA <= 32u && lenB <= 32u) {
                const unsigned len = (lane >> 5) ? lenB : lenA, lmax = lenA > lenB ? lenA : lenB, kr = SELB[2 * tokw + 1];
                const unsigned e = ((unsigned)l5 < len) ? LST[tokw * IX_LCAP + l5] : 0xffffffffu; unsigned G = 0u, E = 0u;
                for (unsigned k = 0; k < lmax; ++k) { const unsigned xr = LST[tokw * IX_LCAP + k]; const unsigned x = k < len ? xr : 0u; G += x > e ? 1u : 0u; E += x == e ? 1u : 0u; }
                LDS_WAIT();
                if ((unsigned)l5 < len && G < kr && kr <= G + E) SELB[2 * tokw] = e;
            } else {
#pragma unroll 1
            for (int tt = 0; tt < 2; ++tt) { const int tok = 2 * w + tt; const unsigned len = __builtin_amdgcn_readfirstlane(LCN[tok]), kr = __builtin_amdgcn_readfirstlane(SELB[2 * tok + 1]);
                const unsigned e = (lane < (int)len) ? LST[tok * IX_LCAP + lane] : 0xffffffffu; unsigned G = 0u, E = 0u;
                for (unsigned k = 0; k < len; ++k) { const unsigned x = LST[tok * IX_LCAP + k]; G += x > e ? 1u : 0u; E += x == e ? 1u : 0u; }
                LDS_WAIT();
                if (lane < (int)len && G < kr && kr <= G + E) SELB[2 * tok] = e;
            }
            }
            IX_LBAR();
            T = SELB[2 * c16];
        } else {
            IX_PASS(2); IX_PASS(3);
            T = prefix;
        }
#undef IX_PASS
    }
    LAS unsigned* MK = (LAS unsigned*)(L + AT_MASK) + (mrow0 + c16) * MK_STR; LAS unsigned* EQ = (LAS unsigned*)(L + AT_EQM) + (mrow0 + c16) * MK_STR;
    const int sh = 16 * (w & 1) + 4 * g;
#pragma unroll 2
    for (int j = 0; j < njw; ++j) { const u32x4 u4 = SC[512 * j]; unsigned ngt = 0u, neq = 0u;
#pragma unroll
        for (int r = 0; r < 4; ++r) { ngt |= (u4[r] > T ? 1u : 0u) << r; neq |= (u4[r] == T ? 1u : 0u) << r; }
        if (T == 1u) { ngt |= neq; neq = 0u; }
        if (ngt) __hip_atomic_fetch_or(&MK[4 * j + (w >> 1)], ngt << sh, __ATOMIC_RELAXED, __HIP_MEMORY_SCOPE_WORKGROUP);
        if (neq) __hip_atomic_fetch_or(&EQ[4 * j + (w >> 1)], neq << sh, __ATOMIC_RELAXED, __HIP_MEMORY_SCOPE_WORKGROUP); }
}
__device__ __forceinline__ void dsa_ties(Frame& F) {
    const int lane = fresh_lane(), tid = F.wave * 64 + lane; LAS uchar* L = F.lds;
    const int tok = tid >> 4, part = lane & 15;
    LAS u32x2* mk = (LAS u32x2*)((LAS unsigned*)(L + AT_MASK) + tok * MK_STR + 4 * part); LAS u32x2* eq = (LAS u32x2*)((LAS unsigned*)(L + AT_EQM) + tok * MK_STR + 4 * part);
    const u32x2 m0 = mk[0], m1 = mk[1], e0 = eq[0], e1 = eq[1];
    int n = (__popc(m0.x) + __popc(m0.y)) + (__popc(m1.x) + __popc(m1.y));
    const unsigned ew[4] = {e0.x, e0.y, e1.x, e1.y};
    const int ce = (__popc(ew[0]) + __popc(ew[1])) + (__popc(ew[2]) + __popc(ew[3]));
    int inc = ce;
#pragma unroll
    for (int o = 1; o < 16; o <<= 1) { n += (int)shxu((unsigned)n, o, lane); const int t = __builtin_amdgcn_ds_bpermute((part >= o ? lane - o : lane) << 2, inc); if (part >= o) inc += t; }
    int take = 256 - n - (inc - ce);
    take = take < 0 ? 0 : (take > ce ? ce : take);
    unsigned sel[4];
#pragma unroll
    for (int i = 0; i < 4; ++i) { const int c = __popc(ew[i]);
        if (take >= c) { sel[i] = ew[i]; take -= c; }
        else { unsigned keep = 0u, e = ew[i]; for (int q = 0; q < take; ++q) { const unsigned low = e & (0u - e); keep |= low; e ^= low; } sel[i] = keep; take = 0; } }
    if (ce) { mk[0] = (u32x2){m0.x | sel[0], m0.y | sel[1]}; mk[1] = (u32x2){m1.x | sel[2], m1.y | sel[3]}; }
}
__device__ __forceinline__ void dsa_unit(Frame& F, int b, int qt) {
    const int tid = F.wave * 64 + fresh_lane();
    LAS uchar* L = F.lds; uchar* ws = F.ws; const int w = F.wave; const int tq0 = 32 * qt;
    IxPre P;
    ix_prefetch(F, b, tq0, P);
    IX_LBAR();
    for (int o = tid * 16; o < 2 * 32 * MK_STR * 4; o += NTHR * 16) *(LAS u32x4*)(L + AT_MASK + o) = (u32x4){0u, 0u, 0u, 0u};
    for (int o = tid * 16; o < 16 * IX_HSTR * 4; o += NTHR * 16) *(LAS u32x4*)(L + IX_H + o) = (u32x4){0u, 0u, 0u, 0u};
    IX_LBAR();
    ix_score(F, b, tq0, P);
    ix_prefetch(F, b, tq0 + 16, P);
    ix_select(F, tq0, 0);
    ix_score(F, b, tq0 + 16, P);
    ix_select(F, tq0 + 16, 16);
    bf16_t* OALL = (bf16_t*)F.out; const size_t row0 = (size_t)b * SEQ + tq0;
    bf16_t* op = OALL + row0 * 2048 + 512 + w * 64;
    dsa_attn(F, OALL + row0 * 2048 + 512 + w * 128, (const bf16_t*)(ws + WS_QR) + (size_t)(b >> 1) * XS_QR + row0 * 256 + w * 32, op, (const bf16_t*)(ws + WS_KV) + (size_t)(b >> 1) * XS_KV + (size_t)b * SEQ * 160, (tq0 + 31) / 64 + 1, (const bf16_t*)(ws + WS_WUVT) + (size_t)w * 8192);
}
__device__ __forceinline__ void mem_unit(Frame& F, int b, int h, int tb) {
    uchar* ws = F.ws; bf16_t* OALL = (bf16_t*)F.out; const size_t row0 = (size_t)b * SEQ + tb * 256 + 32 * F.wave;
    const bf16_t* km = (const bf16_t*)(ws + WS_KM) + (size_t)(b >> 1) * XS_KM + (size_t)b * MEMLEN * 1024 + h * 128;
    __syncthreads();
    bf16_t* op = OALL + row0 * 2048 + 1536 + h * 128;
    attn_unit<false, false>(F, OALL + row0 * 2048 + 1536 + h * 128, 2048, op, 2048, nullptr, 0, km, 1024, km + 512, 1024, 4);
}

__global__ void __launch_bounds__(NTHR, 2) fwd_kernel(Args args) {
    extern __shared__ __attribute__((aligned(16))) uchar lds_raw[];
    Frame F; F.lds = (LAS uchar*)lds_raw; F.wave = __builtin_amdgcn_readfirstlane(threadIdx.x >> 6);
    F.G = gridDim.x; F.c = blockIdx.x; F.vcu = (F.G % 8 == 0) ? (F.c % 8) * (F.G / 8) + F.c / 8 : F.c;
    F.in = args.in; F.out = args.out; F.ws = args.ws;
    uchar* ws = args.ws;
    volatile LAS unsigned* MISC = (volatile LAS unsigned*)(F.lds + MISC_OFF);
    if (threadIdx.x < 64) MISC[threadIdx.x] = 0u;
    __syncthreads();
    XcdBarrier bar = xcd_barrier_post((unsigned*)(ws + WS_CTL) + CW_BAR, MISC + 8);

    p0_prologue(F);
    xcd_barrier(bar, F.wave);
    const bool xmode = __builtin_amdgcn_readfirstlane((int)MISC[10]) != 0;
    const int cs = xmode ? __builtin_amdgcn_readfirstlane((int)MISC[12]) * 8 + __builtin_amdgcn_readfirstlane((int)MISC[13]) : F.c;
    p1_w8_items(F, F.in[3], 6120, 3048, F.in[2], (const unsigned*)(ws + WS_CTL) + CW_COLMAX, 96, ws + WS_W8, (float*)(ws + WS_SW));
    p1_w8_items(F, F.in[21], 4096, 0, F.in[20], (const unsigned*)(ws + WS_CTL) + CW_COLMAXU, 128, ws + WS_WUP, (float*)(ws + WS_SWU));
    p1_w8_items(F, F.in[3], 6120, 0, F.in[2], (const unsigned*)(ws + WS_CTL) + CW_COLMAXP, 64, ws + WS_W8P, (float*)(ws + WS_SWP));
    p1_w8_items(F, F.in[3], 6120, 2536, F.in[2], (const unsigned*)(ws + WS_CTL) + CW_COLMAXP + 2560, 16, ws + WS_W8P + (size_t)2560 * 1024, (float*)(ws + WS_SWP) + 2560);
    asm volatile("s_waitcnt vmcnt(0)" ::: "memory"); __syncthreads();
    if (threadIdx.x == 0) { __builtin_amdgcn_fence(__ATOMIC_RELEASE, "agent"); asm volatile("s_waitcnt vmcnt(0)" ::: "memory"); __hip_atomic_fetch_add((unsigned*)(ws + WS_CTL) + CW_W8DONE, 1u, __ATOMIC_RELAXED, __HIP_MEMORY_SCOPE_AGENT); }
    {
        pg8::Gemm g{(const bf16_t*)(ws + WS_XB), (const bf16_t*)(ws + WS_WIN), 1024, 1024};
        pg8::TileSched S{128, 2, 8, F.G, cs, 16};
        EpiProj E{(const float*)(ws + WS_RSX), (bf16_t*)F.out, (bf16_t*)(ws + WS_HQ), (float*)(ws + WS_G), (bf16_t*)(ws + WS_HV), (bf16_t*)(ws + WS_HV) + 512, (bf16_t*)(ws + WS_CQ), (float*)(ws + WS_CQSS), (float*)(ws + WS_R9), ws + WS_GATES, (const float*)(ws + WS_LB)};
        pg8::gemm_phase(F.lds, F.wave, g, S, E);
    }
    xcd_barrier(bar, F.wave, xmode);
    if (xmode) p2_xq_rows(F, ws + WS_XB, ws + WS_XB, 2048, 4096 * (cs & 7), 4096, (cs >> 3) * NWAVES + F.wave, 32 * NWAVES); else p2_xq_rows(F, ws + WS_XB, ws + WS_XB, 2048, 0, MTOK, F.c * NWAVES + F.wave, F.G * NWAVES);
    if (threadIdx.x == 0) { unsigned sp = 0u; while (__hip_atomic_load((unsigned*)(ws + WS_CTL) + CW_W8DONE, __ATOMIC_RELAXED, __HIP_MEMORY_SCOPE_AGENT) < (unsigned)F.G) { __builtin_amdgcn_s_sleep(2); if (++sp > (1u << 22)) break; } }
    xcd_barrier(bar, F.wave, xmode);
    {
        pg8::Gemm g{(const bf16_t*)(ws + WS_XB), (const bf16_t*)(ws + WS_W8P), 1024, 512};
        pg8::ProjSched S{pg8::TileSched{128, 10, 0, F.G, cs, 8}};
        EpiProj8 E{EpiProj{(const float*)(ws + WS_RSX), (bf16_t*)F.out, (bf16_t*)(ws + WS_HQ), (float*)(ws + WS_G), (bf16_t*)(ws + WS_HV), (bf16_t*)(ws + WS_HV) + 512, (bf16_t*)(ws + WS_CQ), (float*)(ws + WS_CQSS), (float*)(ws + WS_R9), ws + WS_GATES, (const float*)(ws + WS_LB)},
                   (const float*)(ws + WS_SXQ), (const float*)(ws + WS_SWP)};
        pg8::gemm_phase(F.lds, F.wave, g, S, E);
    }
    xcd_barrier(bar, F.wave, xmode);
    { const int xx = cs & 7, rk = cs >> 3;
      const bool hgrole = xmode ? rk < 8 : F.c < 64;
    if (hgrole) { hgrn_chain(F, xmode ? (2 * xx + (rk >> 2)) * 4 + (rk & 3) : F.c);
    }
    else {
        const int G2 = F.G - 64, c2 = F.c - 64, r2 = rk - 8;
        { const int lane = fresh_lane();
          if (xmode) { for (int i = r2 * NWAVES + F.wave; i < 512; i += 24 * NWAVES) kv_prep_grp(F, 512 * xx + i, lane); }
          else { for (int grp = c2 * NWAVES + F.wave; grp < MTOK / 8; grp += G2 * NWAVES) kv_prep_grp(F, grp, lane); } }
        { pg8::Gemm g{(const bf16_t*)(ws + WS_MB), (const bf16_t*)(ws + WS_WKV), 1024, 1024}; pg8::XcdSched S{xmode, pg8::TileSched{16, 4, 0, 64, c2 - 128, 16}, xx, r2 - 16, 8, 2, 4, 0, 16};     EpiKvm E{(const float*)(ws + WS_RSM), (bf16_t*)(ws + WS_KM)};
          pg8::gemm_phase(F.lds, F.wave, g, S, E); }
        { pg8::Gemm g{(const bf16_t*)(ws + WS_CQ), (const bf16_t*)(ws + WS_WDQ), 256, 256, XS_CQ * 2}; pg8::XcdSched S{xmode, pg8::TileSched{128, 7, 0, G2, c2, 4}, xx, r2, 24, 16, 7, 0, 4};
          EpiDq E{(const float*)(ws + WS_CQSS), (bf16_t*)F.out, (bf16_t*)(ws + WS_QR), (bf16_t*)(ws + WS_QI), (const float*)(ws + WS_TAB32), (const float*)(ws + WS_TAB64)};
          pg8::gemm_phase(F.lds, F.wave, g, S, E); }
        { pg8::Gemm g{(const bf16_t*)(ws + WS_XB), (const bf16_t*)(ws + WS_W8), 1024, 512}; pg8::GateSched S{xmode, pg8::TileSched{128, 12, 0, G2, c2, 8}, xx, r2};
          EpiGate8 E{(const float*)(ws + WS_RSX), (const float*)(ws + WS_SXQ), (const float*)(ws + WS_SW), ws + WS_GATES};
          pg8::gemm_phase(F.lds, F.wave, g, S, E); }
    } }
    xcd_barrier(bar, F.wave, xmode);
    { const int P0i = xmode ? 64 * (cs & 7) + (cs >> 3) : F.vcu, Pst = xmode ? 32 : F.G, Pn = xmode ? 2 : (F.vcu < 512 ? (511 - F.vcu) / F.G + 1 : 0);
_Pragma("unroll 1")
      for (int k = 0; k < Pn; ++k) { const int P = P0i + k * Pst, b = P >> 5, x = P & 31;
_Pragma("unroll 1")
        for (int s = 0; s < 2; ++s) dsa_unit(F, b, s ? 63 - x : x); }
_Pragma("unroll 1")
      for (int k = 0; k < Pn; ++k) { const int P = P0i + k * Pst, b = P >> 5, h = (P >> 3) & 3, tb = P & 7; mem_unit(F, b, h, tb); } }
    xcd_barrier(bar, F.wave, xmode);
    { pg8::Gemm g{(const bf16_t*)F.out, (const bf16_t*)(ws + WS_BALL), 2048, 2048}; pg8::MergeSched S{F.G, cs}; EpiMerge E{ws + WS_GATES, (bf16_t*)(ws + WS_MERGED)};
      pg8::gemm_phase(F.lds, F.wave, g, S, E);
    }
    xcd_barrier(bar, F.wave, xmode);
    { pg8::Gemm g{(const bf16_t*)(ws + WS_MERGED), (const bf16_t*)(ws + WS_WOUT), 1024, 1024}; pg8::TileSched S{128, 4, 0, F.G, cs, 16};
      EpiOut E{F.in[0], (bf16_t*)(ws + WS_H1B), (float*)(ws + WS_H1SS)};
      pg8::gemm_phase(F.lds, F.wave, g, S, E);
    }
    xcd_barrier(bar, F.wave, xmode);
    if (xmode) p2_xq_rows(F, ws + WS_H1B, ws + WS_XB, 2048, 4096 * (cs & 7), 4096, (cs >> 3) * NWAVES + F.wave, 32 * NWAVES); else p2_xq_rows(F, ws + WS_H1B, ws + WS_XB, 2048, 0, MTOK, F.c * NWAVES + F.wave, F.G * NWAVES);
    xcd_barrier(bar, F.wave, xmode);
    if (xmode && ((cs >> 3) & 1)) { __builtin_amdgcn_s_sleep(127); __builtin_amdgcn_s_sleep(127); }
    { pg8::Gemm g{(const bf16_t*)(ws + WS_XB), (const bf16_t*)(ws + WS_WUP), 1024, 512}; pg8::UpSched S{xmode, pg8::TileSched{128, 16, 0, F.G, cs, 8}, cs & 7, cs >> 3};
      EpiUp8 E{(bf16_t*)(ws + WS_U), (const float*)(ws + WS_H1SS), (float*)(ws + WS_S2), (const float*)(ws + WS_SXQ), (const float*)(ws + WS_SWU)};
      pg8::gemm_phase(F.lds, F.wave, g, S, E);
    }
    xcd_barrier(bar, F.wave, xmode);
    { pg8::Gemm g{(const bf16_t*)(ws + WS_U), (const bf16_t*)(ws + WS_WDOWN), 4096, 4096}; pg8::TileSched S{128, 4, 0, F.G, cs, 64};
      EpiDownNorm E{F.out, (const bf16_t*)(ws + WS_H1B), (const float*)(ws + WS_S2), F.in[23], (unsigned*)(ws + WS_XCH), (unsigned*)(ws + WS_CTL) + CW_PANEL, F.lds + 131072};
      pg8::gemm_phase(F.lds, F.wave, g, S, E);
    }
}

extern "C" void kernel_launch(void* const* d_in, const int* in_sizes, int n_in, void* d_out, int out_size, void* d_ws, size_t ws_size, hipStream_t stream) {
    static int grid = 0;
    if (grid == 0) {
        if (n_in != 24 || out_size != MTOK * DM || ws_size < WS_END) { fprintf(stderr, "kernel_launch: unexpected shapes (n_in %d, out %d, ws %zu)\n", n_in, out_size, ws_size); grid = -1; return; }
        int dev = 0, cus = 0;
        if (hipGetDevice(&dev) != hipSuccess || hipDeviceGetAttribute(&cus, hipDeviceAttributeMultiprocessorCount, dev) != hipSuccess) { grid = -1; return; }
        if (hipFuncSetAttribute((const void*)fwd_kernel, hipFuncAttributeMaxDynamicSharedMemorySize, LDS_BYTES) != hipSuccess) { fprintf(stderr, "kernel_launch: hipFuncSetAttribute failed\n"); grid = -1; return; }
        (void)hipGetLastError();
        grid = cus;
        if (grid != 256) fprintf(stderr, "kernel_launch: built for 256 CUs, device has %d\n", cus);
    }
    if (grid < 0) return;
    (void)hipMemsetAsync((char*)d_ws + WS_CTL, 0, CTL_ZERO_BYTES, stream);
    Args a{};
    for (int i = 0; i < 24; ++i) a.in[i] = (const float*)d_in[i];
    a.out = (float*)d_out; a.ws = (uchar*)d_ws;
    hipLaunchKernelGGL(fwd_kernel, dim3(grid), dim3(NTHR), LDS_BYTES, stream, a);
}
```

```cpp
constexpr int P0_TW = 6;
#include <hip/hip_runtime.h>
#include <cstdio>
#include <cstdint>

#define LAS __attribute__((address_space(3)))
#define GAS __attribute__((address_space(1)))
typedef unsigned short bf16_t;
typedef short bf16x8 __attribute__((ext_vector_type(8)));
typedef float f32x4 __attribute__((ext_vector_type(4)));
typedef float f32x2 __attribute__((ext_vector_type(2)));
typedef unsigned u32x4 __attribute__((ext_vector_type(4)));
typedef unsigned u32x2 __attribute__((ext_vector_type(2)));
typedef unsigned char uchar;
typedef int i32x4_t __attribute__((ext_vector_type(4)));

constexpr int NB = 16, SEQ = 2048, DM = 1024, MTOK = NB * SEQ, MEMLEN = 256, MMEM = NB * MEMLEN;
constexpr int NIN = 6144;
constexpr int DFF = 4096;
constexpr float EPS = 1e-6f;
constexpr float LOG2E = 1.4426950408889634f;
constexpr int NWAVES = 8, NTHR = 512;
constexpr int LDS_BYTES = 163840;
constexpr int MISC_OFF = LDS_BYTES - 256;

constexpr size_t MiB = 1u << 20;
constexpr size_t WS_CTL = 0, CTL_ZERO_BYTES = 1 * MiB;
constexpr size_t WS_WIN = 1 * MiB;
constexpr size_t WS_W8 = 7 * MiB;
constexpr size_t WS_W8P = 1 * MiB;
constexpr size_t WS_SWP = 10 * MiB + 16384;
constexpr size_t WS_SW = 10 * MiB;
constexpr size_t WS_SXQ = 10 * MiB + 65536;
constexpr size_t WS_SWU = 10 * MiB + 32768;
constexpr size_t WS_WDQ = 13 * MiB;
constexpr size_t WS_WKV = 14 * MiB;
constexpr size_t WS_BALL = 16 * MiB;
constexpr size_t WS_WOUT = 20 * MiB;
constexpr size_t WS_WUP = 22 * MiB;
constexpr size_t WS_WDOWN = 30 * MiB;
constexpr size_t WS_WUVT = 38 * MiB + 786432;
constexpr size_t WS_TAB32 = 38 * MiB;
constexpr size_t WS_TAB64 = WS_TAB32 + 262144;
constexpr size_t WS_RSX = 39 * MiB;
constexpr size_t WS_RSM = WS_RSX + 131072;
constexpr size_t WS_LB = WS_RSM + 16384;
constexpr size_t WS_XCH = 39 * MiB + 262144;
constexpr size_t WS_S2 = 39 * MiB + 786432;
constexpr size_t WS_CQSS = 40 * MiB;
constexpr size_t WS_WIDX = WS_CQSS + 524288;
constexpr size_t WS_H1SS = 42 * MiB;
constexpr size_t WS_XB = 44 * MiB;
constexpr size_t WS_MB = 108 * MiB;
constexpr size_t WS_G = 116 * MiB;
constexpr size_t WS_HV = 180 * MiB;
constexpr size_t WS_REG = 244 * MiB, ARENA = 32 * MiB;
constexpr size_t WS_GATES = WS_REG;
constexpr size_t WS_QI = WS_REG + 12 * MiB;
constexpr size_t WS_HQ = WS_REG + 16 * MiB;
constexpr size_t WS_R9 = WS_REG + 20 * MiB;
constexpr size_t WS_QR = WS_REG + 24 * MiB;
constexpr size_t WS_CQ = WS_REG + 26 * MiB;
constexpr size_t WS_KV = WS_REG + 28 * MiB;
constexpr size_t WS_KIDX = WS_REG + 29 * MiB + 524288;
constexpr size_t WS_KM = WS_REG + 30 * MiB;
__host__ __device__ constexpr size_t xs_bytes(size_t rowbytes, size_t rows_per_group = 4096) { return ARENA - rows_per_group * rowbytes; }
constexpr size_t XS_GATES = xs_bytes(3072), XS_QI = xs_bytes(1024) / 2, XS_HQ = xs_bytes(1024) / 2, XS_R9 = xs_bytes(1024) / 4, XS_QR = xs_bytes(512) / 2, XS_CQ = xs_bytes(512) / 2,
                 XS_KV = xs_bytes(320) / 2, XS_KIDX = xs_bytes(128) / 2, XS_KM = xs_bytes(2048, 512) / 2;
constexpr size_t WS_MERGED = 116 * MiB;
constexpr size_t WS_H1B = 180 * MiB;
constexpr size_t WS_U = 244 * MiB;
constexpr size_t WS_END = 500 * MiB;
static_assert(WS_REG + 8 * ARENA == WS_END, "arena map");
constexpr int GATE_TILES_P2 = 6;
constexpr int CW_BAR = 4096;
constexpr int CW_W8DONE = 81920;
constexpr int CW_COLMAXP = 75776;
constexpr int CW_COLMAXU = 69632;
constexpr int CW_COLMAX = 65536;

typedef __bf16 bf16x2_t __attribute__((ext_vector_type(2)));
__device__ __forceinline__ unsigned cvt_pk_bf16(float lo, float hi) { const f32x2 v = {lo, hi}; const bf16x2_t b = __builtin_convertvector(v, bf16x2_t); return __builtin_bit_cast(unsigned, b); }
__device__ __forceinline__ float bf_lo(unsigned u) { return __uint_as_float(u << 16); }
__device__ __forceinline__ float bf_hi(unsigned u) { return __uint_as_float(u & 0xffff0000u); }
__device__ __forceinline__ float fast_exp(float x) { return __builtin_amdgcn_exp2f(x * LOG2E); }
__device__ __forceinline__ float fast_sigmoid(float x) { return __builtin_amdgcn_rcpf(1.0f + fast_exp(-x)); }
__device__ __forceinline__ f32x4 mma16(bf16x8 rowop, bf16x8 colop, f32x4 c) { return __builtin_amdgcn_mfma_f32_16x16x32_bf16(rowop, colop, c, 0, 0, 0); }
__device__ __forceinline__ int fresh_lane() { unsigned m = ~0u; asm volatile("" : "+s"(m)); int l = __builtin_amdgcn_mbcnt_hi(m, __builtin_amdgcn_mbcnt_lo(m, 0u)); asm volatile("" : "+v"(l)); return l; }
__device__ __forceinline__ float shx(float v, int o, int lane) { return __uint_as_float((unsigned)__builtin_amdgcn_ds_bpermute((lane ^ o) << 2, (int)__float_as_uint(v))); }
__device__ __forceinline__ unsigned shxu(unsigned v, int o, int lane) { return (unsigned)__builtin_amdgcn_ds_bpermute((lane ^ o) << 2, (int)v); }
__device__ __forceinline__ float shdn(float v, int o, int lane) { const int p = lane + o < 64 ? lane + o : lane; return __uint_as_float((unsigned)__builtin_amdgcn_ds_bpermute(p << 2, (int)__float_as_uint(v))); }
__device__ __forceinline__ unsigned shdnu(unsigned v, int o, int lane) { const int p = lane + o < 64 ? lane + o : lane; return (unsigned)__builtin_amdgcn_ds_bpermute(p << 2, (int)v); }
#define LDS_WAIT() asm volatile("s_waitcnt lgkmcnt(0)" ::: "memory")
#define VM_WAIT() asm volatile("s_waitcnt vmcnt(0)" ::: "memory")
__device__ __forceinline__ int sw256(int row, int ch) { return row * 256 + ((ch ^ (row & 15)) << 4); }
__device__ __forceinline__ int sw128(int row, int ch) { return row * 128 + ((ch ^ ((row >> 1) & 7)) << 4); }
__device__ __forceinline__ int sw64(int row, int ch) { return row * 64 + ((ch ^ ((0x78 >> (((row >> 2) & 3) * 2)) & 3)) << 4); }

namespace pg8 {
constexpr int BM = 256, BK = 64, HALF = 128, HTB = HALF * BK * 2, STAGE_BYTES = 8 * HTB, NXCD = 8, WGM = 8;
__host__ __device__ __forceinline__ int lds_byte(int r, int c) { const int st = (r >> 4) * 2 + (c >> 5), rr = r & 15, cc = c & 31, ob = rr * 64 + cc * 2; return st * 1024 + (ob ^ (((ob >> 9) & 1) << 5)); }
__host__ __device__ __forceinline__ void stage_rc(int b, int& R, int& C) { const int st = b / 1024, sb = b % 1024, swz = sb ^ (((sb >> 9) & 1) << 5); R = (st >> 1) * 16 + swz / 64; C = (st & 1) * 32 + (swz % 64) / 2; }
__host__ __device__ __forceinline__ int perm32(int rho) { const int n = rho >> 4, i = rho & 15; return 8 * (i >> 2) + 4 * n + (i & 3); }

struct Unit { int pm, pn, k0, nt, tag; };
struct Gemm { const bf16_t* A; const bf16_t* Bt; int lda, ldb; size_t axs = 0; };

__device__ __forceinline__ void tile_of(int L, int nM, int nN, int& pm, int& pn) {
    const int nwg = nM * nN; int wgid = L;
    { const int q = nwg / NXCD, r = nwg % NXCD, xcd = wgid % NXCD, off = wgid / NXCD; wgid = (xcd < r ? xcd * (q + 1) : r * (q + 1) + (xcd - r) * q) + off; }
    const int nig = WGM * nN, gid = wgid / nig, fm = gid * WGM, gsz = (nM - fm) < WGM ? (nM - fm) : WGM;
    pm = fm + ((wgid % nig) % gsz); pn = (wgid % nig) / gsz;
}
struct TileSched {
    int nM, nN, pn0, G, c, nt;
    __device__ __forceinline__ bool next(int i, Unit& u) const {
        const long L = (long)i * G + c; if (c < 0 || L >= (long)nM * nN) return false;
        int pm, pn; tile_of((int)L, nM, nN, pm, pn); u.pm = pm; u.pn = pn + pn0; u.k0 = 0; u.nt = nt; u.tag = 0; return true;
    }
};
struct XcdSched {
    bool xm; TileSched t; int x, r, nr, npm, npn, pn0, nt;
    __device__ __forceinline__ bool next(int i, Unit& u) const {
        if (!xm) return t.next(i, u);
        const int q = i * nr + r; if (r < 0 || q >= npm * npn) return false;
        u.pm = npm * x + q % npm; u.pn = pn0 + q / npm; u.k0 = 0; u.nt = nt; u.tag = 0; return true;
    }
};
struct GateSched {
    bool xm; TileSched t; int x, r2;
    __device__ __forceinline__ bool next(int i, Unit& u) const {
        if (!xm) return t.next(i, u);
        if (i >= 8) return false;
        u.pm = 16 * x + 4 * (i & 3) + (r2 & 3); u.pn = 6 * (i >> 2) + (r2 >> 2); u.k0 = 0; u.nt = 8; u.tag = 0; return true;
    }
};
struct ProjSched {
    TileSched t;
    __device__ __forceinline__ bool next(int i, Unit& u) const { if (!t.next(i, u)) return false; if (u.pn >= 8) u.pn += 2; return true; }
};
struct UpSched {
    bool xm; TileSched t; int x, rk;
    __device__ __forceinline__ bool next(int i, Unit& u) const {
        if (!xm) return t.next(i, u);
        if (i >= 8) return false;
        const int idx = ((i & 4) | ((i + x) & 3)) * 32 + rk;
        u.pm = 16 * x + 8 * (idx >> 7) + (idx & 7); u.pn = (idx & 127) >> 3; u.k0 = 0; u.nt = 8; u.tag = 0; return true;
    }
};
struct MergeSched {
    int G, c;
    __device__ __forceinline__ bool next(int i, Unit& u) const {
        const int ti = i / 3, s = i - 3 * ti; const long L = (long)ti * G + c; if (L >= 512) return false;
        const int sub = s;
        int pm, pn; tile_of((int)L, 128, 4, pm, pn); u.pm = pm; u.pn = pn; u.tag = sub | (sub < 2 ? 32 : 0);
        u.k0 = sub == 0 ? 0 : (sub == 1 ? 512 : 1536); u.nt = 8; return true;
    }
};

#define PG8_LAS LAS
typedef int i32x4 __attribute__((ext_vector_type(4)));
template <bool I8> __device__ __forceinline__ f32x4 mma_sel(bf16x8 b, bf16x8 a, f32x4 c) {
    if constexpr (I8) return __builtin_bit_cast(f32x4, __builtin_amdgcn_mfma_i32_16x16x64_i8(__builtin_bit_cast(i32x4, b), __builtin_bit_cast(i32x4, a), __builtin_bit_cast(i32x4, c), 0, 0, 0));
    else return __builtin_amdgcn_mfma_f32_16x16x32_bf16(b, a, c, 0, 0, 0);
}
template <class Epi, class Sched>
__device__ __forceinline__ void gemm_phase(PG8_LAS unsigned char* lds, const int wid, const Gemm g, const Sched& S, const Epi& E) {
    const int lane = fresh_lane(), tid = wid * 64 + lane, wr = wid >> 2, wc = wid & 3, fr = lane & 15, fq = lane >> 4;
    unsigned voffA[2], voffB[2];
#pragma unroll
    for (int i = 0; i < 2; ++i) { int R, C; stage_rc(tid * 16 + i * 8192, R, C); const int Rb = Epi::PERM ? ((R & ~31) + perm32(R & 31)) : R;
        voffA[i] = (unsigned)(R * g.lda + C) * 2u; voffB[i] = (unsigned)(Rb * g.ldb + C) * 2u; }
    const size_t kstep = (size_t)(BK * 2);
    const size_t hstepA = (size_t)HALF * g.lda * 2, hstepB = (size_t)HALF * g.ldb * 2;
    const size_t tstepA = 2 * hstepA, tstepB = 2 * hstepB;
    const unsigned ldsw = (unsigned)wid * 1024u;
    const int aoff = lds_byte(wr * 64 + fr, fq * 8), boff = lds_byte(wc * 32 + fr, fq * 8);
#define PG8_SA(b, h) (((b) * 2 + (h)) * HTB)
#define PG8_SB(b, h) ((4 + (b) * 2 + (h)) * HTB)
#define PG8_STAGE(bufoff, gbase, voff) do { _Pragma("unroll") for (int _i = 0; _i < 2; ++_i) \
        __builtin_amdgcn_global_load_lds((const unsigned*)((const char*)(gbase) + (voff)[_i]), (PG8_LAS unsigned*)(lds + (bufoff) + ldsw + _i * 8192), 16, 0, 0); } while (0)
#define PG8_LDA(dst, b, h) do { _Pragma("unroll") for (int m = 0; m < 4; ++m) _Pragma("unroll") for (int k = 0; k < 2; ++k) dst[m][k] = *(const PG8_LAS bf16x8*)(lds + PG8_SA(b, h) + aoff + m * 2048 + k * 1024); } while (0)
#define PG8_LDB(dst, b, h) do { _Pragma("unroll") for (int n = 0; n < 2; ++n) _Pragma("unroll") for (int k = 0; k < 2; ++k) dst[n][k] = *(const PG8_LAS bf16x8*)(lds + PG8_SB(b, h) + boff + n * 2048 + k * 1024); } while (0)
#define PG8_MMA(ai, bj, At, Bt) do { __builtin_amdgcn_s_setprio(1); _Pragma("unroll") for (int m = 0; m < 4; ++m) _Pragma("unroll") for (int n = 0; n < 2; ++n) _Pragma("unroll") for (int k = 0; k < 2; ++k) \
        acc[ai][bj][m][n] = mma_sel<Epi::I8>(Bt[n][k], At[m][k], acc[ai][bj][m][n]); __builtin_amdgcn_s_setprio(0); } while (0)
#define PG8_WAIT_V(n) asm volatile("s_waitcnt vmcnt(" #n ")" ::: "memory")
#define PG8_WAIT_L(n) asm volatile("s_waitcnt lgkmcnt(" #n ")" ::: "memory")
#define PG8_BAR __builtin_amdgcn_s_barrier()
#define PG8_SCHED __builtin_amdgcn_sched_barrier(0)
    Unit cur, nxt; int ui = 0;
    if (!S.next(0, cur)) return;
    f32x4 acc[2][2][4][2];
#pragma unroll
    for (int a = 0; a < 2; ++a)
#pragma unroll
        for (int b = 0; b < 2; ++b)
#pragma unroll
            for (int m = 0; m < 4; ++m)
#pragma unroll
                for (int n = 0; n < 2; ++n) acc[a][b][m][n] = (f32x4){0.f, 0.f, 0.f, 0.f};
    bf16x8 At[4][2], B0[2][2], B1[2][2];
    const char* cA = (const char*)g.A + (size_t)cur.pm * tstepA + (size_t)(cur.pm >> 4) * g.axs + (size_t)cur.k0 * 2; const char* cB = (const char*)g.Bt + (size_t)cur.pn * tstepB + (size_t)cur.k0 * 2;
    {
        PG8_STAGE(PG8_SB(0, 0), cB, voffB); PG8_STAGE(PG8_SB(0, 1), cB + hstepB, voffB); PG8_STAGE(PG8_SA(0, 0), cA, voffA); PG8_STAGE(PG8_SA(0, 1), cA + hstepA, voffA);
        if (wr == 1) PG8_BAR;
        PG8_WAIT_V(2); PG8_BAR;
        PG8_STAGE(PG8_SB(1, 0), cB + kstep, voffB); PG8_STAGE(PG8_SA(1, 0), cA + kstep, voffA); PG8_STAGE(PG8_SB(1, 1), cB + hstepB + kstep, voffB);
        PG8_WAIT_V(6); PG8_BAR;
    }
    for (;;) {
        const bool has_next = S.next(ui + 1, nxt);
        const char* nA = has_next ? (const char*)g.A + (size_t)nxt.pm * tstepA + (size_t)(nxt.pm >> 4) * g.axs + (size_t)nxt.k0 * 2 : cA; const char* nB = has_next ? (const char*)g.Bt + (size_t)nxt.pn * tstepB + (size_t)nxt.k0 * 2 : cB;
        const int nt = cur.nt;
        for (int t = 0; t < nt; t += 2) {
            const bool last = (t == nt - 2);
            const char* a1 = cA + (size_t)(t + 1) * kstep;
            const char* a2 = last ? nA : cA + (size_t)(t + 2) * kstep; const char* b2 = last ? nB : cB + (size_t)(t + 2) * kstep;
            const char* a3 = a2 + kstep; const char* b3 = b2 + kstep;
            PG8_LDB(B0, 0, 0); PG8_LDB(B1, 0, 1); PG8_SCHED; PG8_LDA(At, 0, 0); PG8_STAGE(PG8_SA(1, 1), a1 + hstepA, voffA);
            PG8_WAIT_V(8); PG8_WAIT_L(0); PG8_BAR; PG8_MMA(0, 0, At, B0); PG8_MMA(0, 1, At, B1); PG8_BAR; PG8_SCHED;
            PG8_LDA(At, 0, 1); PG8_STAGE(PG8_SB(0, 0), b2, voffB); PG8_STAGE(PG8_SB(0, 1), b2 + hstepB, voffB); PG8_STAGE(PG8_SA(0, 0), a2, voffA);
            PG8_WAIT_V(8); PG8_WAIT_L(0); PG8_BAR; PG8_MMA(1, 0, At, B0); PG8_MMA(1, 1, At, B1); PG8_BAR; PG8_SCHED;
            PG8_LDB(B0, 1, 0); PG8_LDB(B1, 1, 1); PG8_SCHED; PG8_LDA(At, 1, 0); PG8_STAGE(PG8_SA(0, 1), a2 + hstepA, voffA);
            PG8_WAIT_V(8); PG8_WAIT_L(0); PG8_BAR; PG8_MMA(0, 0, At, B0); PG8_MMA(0, 1, At, B1); PG8_BAR; PG8_SCHED;
            PG8_LDA(At, 1, 1); PG8_STAGE(PG8_SB(1, 0), b3, voffB); PG8_STAGE(PG8_SB(1, 1), b3 + hstepB, voffB); PG8_STAGE(PG8_SA(1, 0), a3, voffA);
            PG8_WAIT_V(8); PG8_WAIT_L(0); PG8_BAR; PG8_MMA(1, 0, At, B0); PG8_MMA(1, 1, At, B1); PG8_BAR; PG8_SCHED;
        }
        if (wr == 0) PG8_BAR;
        E(acc, cur, wr, wc, fr, fq);
        if (!has_next) break;
        if (!(Epi::FUSE && (cur.tag & 32))) {
#pragma unroll
        for (int a = 0; a < 2; ++a)
#pragma unroll
            for (int b = 0; b < 2; ++b)
#pragma unroll
                for (int m = 0; m < 4; ++m)
#pragma unroll
                    for (int n = 0; n < 2; ++n) acc[a][b][m][n] = (f32x4){0.f, 0.f, 0.f, 0.f};
        }
        cur = nxt; cA = nA; cB = nB; ++ui;
        if (wr == 1) PG8_BAR;
    }
    PG8_WAIT_V(0);
    PG8_BAR;
#undef PG8_SA
#undef PG8_SB
#undef PG8_STAGE
#undef PG8_LDA
#undef PG8_LDB
#undef PG8_MMA
#undef PG8_WAIT_V
#undef PG8_WAIT_L
#undef PG8_BAR
#undef PG8_SCHED
}
}
using pg8::Unit;

#define XLANE (fq * 16 + fr)
#define EPI_ROWS_BEGIN _Pragma("unroll") for (int ai = 0; ai < 2; ++ai) _Pragma("unroll") for (int m = 0; m < 4; ++m) { const int row = u.pm * 256 + ai * 128 + wr * 64 + m * 16 + fr;
#define EPI_ROWS_END }
__device__ __forceinline__ u32x4 pack8(const f32x4 a, const f32x4 b) { u32x4 w; w.x = cvt_pk_bf16(a[0], a[1]); w.y = cvt_pk_bf16(a[2], a[3]); w.z = cvt_pk_bf16(b[0], b[1]); w.w = cvt_pk_bf16(b[2], b[3]); return w; }

struct EpiProj {
    static constexpr bool PERM = true; static constexpr bool FUSE = false; static constexpr bool I8 = false;
    const float* rsx; bf16_t* oall; bf16_t* hq; float* G; bf16_t* hv; bf16_t* sg; bf16_t* cq; float* cqss; float* r9; uchar* gates; const float* lb;
    __device__ __forceinline__ void operator()(const f32x4 (&acc)[2][2][4][2], const Unit& u, int wr, int wc, int fr, int fq) const {
        const int pn = u.pn; const int cw = wc * 32 + 8 * fq; const size_t xg = (size_t)(u.pm >> 4);
        float rsv[2][4];
#pragma unroll
        for (int ai = 0; ai < 2; ++ai)
#pragma unroll
            for (int m = 0; m < 4; ++m) rsv[ai][m] = rsx[u.pm * 256 + ai * 128 + wr * 64 + m * 16 + fr];
        if (pn < 2 || (pn >= 4 && pn < 8) || pn == 10 || pn == 11) {
            bf16_t* base; int ld, c0; int mode = 0; float sc = 1.f;
            if (pn < 2) { base = hq + xg * XS_HQ; ld = 512; c0 = pn * 256; }
            else if (pn < 6) { base = hv; ld = 1024; c0 = (pn - 4) * 256; }
            else if (pn < 8) { base = hv; ld = 1024; c0 = 512 + (pn - 6) * 256; mode = 1; }
            else { base = oall; ld = 2048; c0 = 1536 + (pn - 10) * 256; sc = 0.08838834764831845f * LOG2E; }
            EPI_ROWS_BEGIN const float rs = rsv[ai][m] * sc;
#pragma unroll
                for (int bj = 0; bj < 2; ++bj) { f32x4 v0 = acc[ai][bj][m][0] * rs, v1 = acc[ai][bj][m][1] * rs;
                    if (mode == 1) {
#pragma unroll
                        for (int e = 0; e < 4; ++e) { v0[e] = v0[e] * fast_sigmoid(v0[e]); v1[e] = v1[e] * fast_sigmoid(v1[e]); } }
                    *(u32x4*)(base + (size_t)row * ld + c0 + bj * 128 + cw) = pack8(v0, v1); }
            EPI_ROWS_END
        } else if (pn < 4) {
            f32x4 lbv[2][2];
#pragma unroll
            for (int bj = 0; bj < 2; ++bj) { const int ch = (pn - 2) * 256 + bj * 128 + cw; lbv[bj][0] = *(const f32x4*)(lb + ch); lbv[bj][1] = *(const f32x4*)(lb + ch + 4); }
            EPI_ROWS_BEGIN const float rs = rsv[ai][m];
#pragma unroll
                for (int bj = 0; bj < 2; ++bj) { const int ch = (pn - 2) * 256 + bj * 128 + cw; const f32x4 l0 = lbv[bj][0], l1 = lbv[bj][1];
                    f32x4 v0 = acc[ai][bj][m][0] * rs, v1 = acc[ai][bj][m][1] * rs;
#pragma unroll
                    for (int e = 0; e < 4; ++e) { v0[e] = __logf(l0[e] + (1.f - l0[e]) * fast_sigmoid(v0[e])); v1[e] = __logf(l1[e] + (1.f - l1[e]) * fast_sigmoid(v1[e])); }
                    float* p = G + (size_t)row * 512 + ch; *(f32x4*)p = v0; *(f32x4*)(p + 4) = v1; }
            EPI_ROWS_END
        } else if (pn == 8) {
            EPI_ROWS_BEGIN const float rs = rsv[ai][m]; float ss = 0.f;
#pragma unroll
                for (int bj = 0; bj < 2; ++bj) { const f32x4 v0 = acc[ai][bj][m][0] * rs, v1 = acc[ai][bj][m][1] * rs;
#pragma unroll
                    for (int e = 0; e < 4; ++e) ss += v0[e] * v0[e] + v1[e] * v1[e];
                    *(u32x4*)(cq + xg * XS_CQ + (size_t)row * 256 + bj * 128 + cw) = pack8(v0, v1); }
                ss += shx(ss, 16, XLANE); ss += shx(ss, 32, XLANE);
                if (fq == 0) cqss[row * 4 + wc] = ss;
            EPI_ROWS_END
        } else if (pn == 9) {
            EPI_ROWS_BEGIN const float rs = rsv[ai][m];
#pragma unroll
                for (int bj = 0; bj < 2; ++bj) { float* p = r9 + xg * XS_R9 + (size_t)row * 256 + bj * 128 + cw; *(f32x4*)p = acc[ai][bj][m][0] * rs; *(f32x4*)(p + 4) = acc[ai][bj][m][1] * rs; }
            EPI_ROWS_END
        } else {
            const int c0 = (pn - 12) * 256;
            EPI_ROWS_BEGIN const float rs = rsv[ai][m];
#pragma unroll
                for (int bj = 0; bj < 2; ++bj) { const f32x4 v0 = acc[ai][bj][m][0] * rs, v1 = acc[ai][bj][m][1] * rs; unsigned q[8];
#pragma unroll
                    for (int e = 0; e < 4; ++e) { q[e] = (unsigned)fmaxf(255.f * fast_sigmoid(v0[e]) + 0.5f, 1.f); q[4 + e] = (unsigned)fmaxf(255.f * fast_sigmoid(v1[e]) + 0.5f, 1.f);     }
                    u32x2 w; w.x = q[0] | (q[1] << 8) | (q[2] << 16) | (q[3] << 24); w.y = q[4] | (q[5] << 8) | (q[6] << 16) | (q[7] << 24);
                    *(u32x2*)(gates + xg * XS_GATES + (size_t)row * 3072 + c0 + bj * 128 + cw) = w; }
            EPI_ROWS_END
        }
    }
};
struct EpiProj8 {
    static constexpr bool PERM = true; static constexpr bool FUSE = false; static constexpr bool I8 = true;
    EpiProj base; const float* sxq; const float* swp;
    __device__ __forceinline__ void operator()(f32x4 (&acc)[2][2][4][2], const Unit& u, int wr, int wc, int fr, int fq) const {
        const int cw = wc * 32 + 8 * fq;
        f32x4 swv[2][2];
#pragma unroll
        for (int bj = 0; bj < 2; ++bj) { swv[bj][0] = *(const f32x4*)(swp + u.pn * 256 + bj * 128 + cw); swv[bj][1] = *(const f32x4*)(swp + u.pn * 256 + bj * 128 + cw + 4); }
        EPI_ROWS_BEGIN const float rs = sxq[row];
#pragma unroll
            for (int bj = 0; bj < 2; ++bj) { const i32x4_t a0 = __builtin_bit_cast(i32x4_t, acc[ai][bj][m][0]), a1 = __builtin_bit_cast(i32x4_t, acc[ai][bj][m][1]); f32x4 v0, v1;
#pragma unroll
                for (int e = 0; e < 4; ++e) { v0[e] = (float)a0[e] * rs * swv[bj][0][e]; v1[e] = (float)a1[e] * rs * swv[bj][1][e]; }
                acc[ai][bj][m][0] = v0; acc[ai][bj][m][1] = v1; }
        EPI_ROWS_END
        base(acc, u, wr, wc, fr, fq);
    }
};
struct EpiKvm {
    static constexpr bool PERM = true; static constexpr bool FUSE = false; static constexpr bool I8 = false;
    const float* rsm; bf16_t* km;
    __device__ __forceinline__ void operator()(const f32x4 (&acc)[2][2][4][2], const Unit& u, int wr, int wc, int fr, int fq) const {
        const int cw = u.pn * 256 + wc * 32 + 8 * fq;
        float rsv[2][4];
#pragma unroll
        for (int ai = 0; ai < 2; ++ai)
#pragma unroll
            for (int m = 0; m < 4; ++m) rsv[ai][m] = rsm[u.pm * 256 + ai * 128 + wr * 64 + m * 16 + fr];
        EPI_ROWS_BEGIN const float rs = rsv[ai][m];
#pragma unroll
            for (int bj = 0; bj < 2; ++bj) *(u32x4*)(km + (size_t)(u.pm >> 1) * XS_KM + (size_t)row * 1024 + bj * 128 + cw) = pack8(acc[ai][bj][m][0] * rs, acc[ai][bj][m][1] * rs);
        EPI_ROWS_END
    }
};
struct EpiDq {
    static constexpr bool PERM = true; static constexpr bool FUSE = false; static constexpr bool I8 = false;
    const float* cqss; bf16_t* oall; bf16_t* qr; bf16_t* qi; const float* tab32; const float* tab64;
    __device__ __forceinline__ void operator()(const f32x4 (&acc)[2][2][4][2], const Unit& u, int wr, int wc, int fr, int fq) const {
        const int pn = u.pn; const int cw = wc * 32 + 8 * fq;
#pragma unroll
        for (int ai = 0; ai < 2; ++ai) {
            f32x4 s4[4]; f32x4 cs[4][2][2];
#pragma unroll
            for (int m = 0; m < 4; ++m) { const int row = u.pm * 256 + ai * 128 + wr * 64 + m * 16 + fr; const int t = row & (SEQ - 1); s4[m] = *(const f32x4*)(cqss + (size_t)row * 4);
                if (pn >= 4) {
#pragma unroll
                    for (int bj = 0; bj < 2; ++bj) { const int cc = bj * 128 + cw; const int c5 = (pn - 5) * 256 + cc;
                        const float* tp = (pn == 4) ? tab32 + ((size_t)t * 16 + ((cc & 31) >> 1)) * 2 : tab64 + ((size_t)t * 32 + ((c5 & 63) >> 1)) * 2;
                        cs[m][bj][0] = *(const f32x4*)tp; cs[m][bj][1] = *(const f32x4*)(tp + 4); } } }
#pragma unroll
            for (int m = 0; m < 4; ++m) { const int row = u.pm * 256 + ai * 128 + wr * 64 + m * 16 + fr; const float rs = rsqrtf((s4[m][0] + s4[m][1] + s4[m][2] + s4[m][3]) * (1.f / 256.f) + EPS);
#pragma unroll
                for (int bj = 0; bj < 2; ++bj) { f32x4 v0 = acc[ai][bj][m][0] * rs, v1 = acc[ai][bj][m][1] * rs; const int cc = bj * 128 + cw;
                    if (pn < 4) { *(u32x4*)(oall + (size_t)row * 2048 + 512 + pn * 256 + cc) = pack8(v0, v1); }
                    else {
                        bf16_t* op = (pn == 4) ? qr + (size_t)(u.pm >> 4) * XS_QR + (size_t)row * 256 + cc : qi + (size_t)(u.pm >> 4) * XS_QI + (size_t)row * 512 + (pn - 5) * 256 + cc;
                        const f32x4 cs0 = cs[m][bj][0], cs1 = cs[m][bj][1];
                        f32x4 o0, o1;
                        o0[0] = v0[0] * cs0[0] - v0[1] * cs0[1]; o0[1] = v0[1] * cs0[0] + v0[0] * cs0[1];
                        o0[2] = v0[2] * cs0[2] - v0[3] * cs0[3]; o0[3] = v0[3] * cs0[2] + v0[2] * cs0[3];
                        o1[0] = v1[0] * cs1[0] - v1[1] * cs1[1]; o1[1] = v1[1] * cs1[0] + v1[0] * cs1[1];
                        o1[2] = v1[2] * cs1[2] - v1[3] * cs1[3]; o1[3] = v1[3] * cs1[2] + v1[2] * cs1[3];
                        *(u32x4*)op = pack8(o0, o1);
                    } } }
        }
    }
};
struct EpiMerge {
    static constexpr bool PERM = true; static constexpr bool FUSE = true; static constexpr bool I8 = false;
    const uchar* gates; bf16_t* merged;
    __device__ __forceinline__ void operator()(f32x4 (&acc)[2][2][4][2], const Unit& u, int wr, int wc, int fr, int fq) const {
        const int cw = u.pn * 256 + wc * 32 + 8 * fq; const int sub = u.tag & 15;
#pragma unroll
        for (int ai = 0; ai < 2; ++ai) {
            u32x2 gn[4][2], gd[4][2];
#pragma unroll
            for (int m = 0; m < 4; ++m) { const int row = u.pm * 256 + ai * 128 + wr * 64 + m * 16 + fr;
#pragma unroll
                for (int bj = 0; bj < 2; ++bj) { const uchar* gp = gates + (size_t)(u.pm >> 4) * XS_GATES + (size_t)row * 3072 + sub * 1024 + bj * 128 + cw; gn[m][bj] = *(const u32x2*)gp; gd[m][bj] = sub < 2 ? *(const u32x2*)(gp + 1024) : (u32x2){0u, 0u}; } }
#pragma unroll
            for (int m = 0; m < 4; ++m) { const int row = u.pm * 256 + ai * 128 + wr * 64 + m * 16 + fr;
#pragma unroll
                for (int bj = 0; bj < 2; ++bj) { const u32x2 n2 = gn[m][bj], d2 = gd[m][bj];
                    float f[8];
#pragma unroll
                    for (int e = 0; e < 8; ++e) { const float qn = (float)(((e < 4 ? n2.x : n2.y) >> (8 * (e & 3))) & 255u);
                        f[e] = sub < 2 ? qn * __builtin_amdgcn_rcpf((float)(((e < 4 ? d2.x : d2.y) >> (8 * (e & 3))) & 255u)) : qn * (1.f / 255.f); }
                    f32x4 v0 = acc[ai][bj][m][0], v1 = acc[ai][bj][m][1];
                    v0[0] *= f[0]; v0[1] *= f[1]; v0[2] *= f[2]; v0[3] *= f[3]; v1[0] *= f[4]; v1[1] *= f[5]; v1[2] *= f[6]; v1[3] *= f[7];
                    if (sub < 2) { acc[ai][bj][m][0] = v0; acc[ai][bj][m][1] = v1; }
                    else *(u32x4*)(merged + (size_t)row * 1024 + bj * 128 + cw) = pack8(v0, v1); } }
        }
    }
};
struct EpiGate8 {
    static constexpr bool PERM = true; static constexpr bool FUSE = false; static constexpr bool I8 = true;
    const float* rsx; const float* sxq; const float* sw; uchar* gates;
    __device__ __forceinline__ void operator()(const f32x4 (&acc)[2][2][4][2], const Unit& u, int wr, int wc, int fr, int fq) const {
        const int c0 = u.pn * 256, cw = wc * 32 + 8 * fq; const size_t xg = (size_t)(u.pm >> 4);
        f32x4 swv[2][2];
#pragma unroll
        for (int bj = 0; bj < 2; ++bj) { swv[bj][0] = *(const f32x4*)(sw + c0 + bj * 128 + cw); swv[bj][1] = *(const f32x4*)(sw + c0 + bj * 128 + cw + 4); }
        float rsv[2][4];
#pragma unroll
        for (int ai = 0; ai < 2; ++ai)
#pragma unroll
            for (int m = 0; m < 4; ++m) { const int row = u.pm * 256 + ai * 128 + wr * 64 + m * 16 + fr; rsv[ai][m] = rsx[row] * sxq[row]; }
        EPI_ROWS_BEGIN const float rs = rsv[ai][m];
#pragma unroll
            for (int bj = 0; bj < 2; ++bj) { const i32x4_t a0 = __builtin_bit_cast(i32x4_t, acc[ai][bj][m][0]), a1 = __builtin_bit_cast(i32x4_t, acc[ai][bj][m][1]); unsigned q[8];
#pragma unroll
                for (int e = 0; e < 4; ++e) { q[e] = (unsigned)fmaxf(255.f * fast_sigmoid((float)a0[e] * rs * swv[bj][0][e]) + 0.5f, 1.f); q[4 + e] = (unsigned)fmaxf(255.f * fast_sigmoid((float)a1[e] * rs * swv[bj][1][e]) + 0.5f, 1.f); }
                u32x2 w; w.x = q[0] | (q[1] << 8) | (q[2] << 16) | (q[3] << 24); w.y = q[4] | (q[5] << 8) | (q[6] << 16) | (q[7] << 24);
                *(u32x2*)(gates + xg * XS_GATES + (size_t)row * 3072 + c0 + bj * 128 + cw) = w; }
        EPI_ROWS_END
    }
};
struct EpiOut {
    static constexpr bool PERM = true; static constexpr bool FUSE = false; static constexpr bool I8 = false;
    const float* xf; bf16_t* h1b; float* h1ss;
    __device__ __forceinline__ void operator()(const f32x4 (&acc)[2][2][4][2], const Unit& u, int wr, int wc, int fr, int fq) const {
        const int cw = u.pn * 256 + wc * 32 + 8 * fq;
#pragma unroll
        for (int ai = 0; ai < 2; ++ai) {
#pragma unroll
            for (int mp = 0; mp < 2; ++mp) {
            f32x4 xr[2][2][2];
#pragma unroll
            for (int m2 = 0; m2 < 2; ++m2) { const int row = u.pm * 256 + ai * 128 + wr * 64 + (2 * mp + m2) * 16 + fr;
#pragma unroll
                for (int bj = 0; bj < 2; ++bj) { const float* p = xf + (size_t)row * 1024 + bj * 128 + cw; xr[m2][bj][0] = *(const f32x4*)p; xr[m2][bj][1] = *(const f32x4*)(p + 4); } }
#pragma unroll
            for (int m2 = 0; m2 < 2; ++m2) { const int m = 2 * mp + m2; const int row = u.pm * 256 + ai * 128 + wr * 64 + m * 16 + fr; float ss = 0.f;
#pragma unroll
                for (int bj = 0; bj < 2; ++bj) { const size_t off = (size_t)row * 1024 + bj * 128 + cw;
                    f32x4 v0 = acc[ai][bj][m][0] + xr[m2][bj][0], v1 = acc[ai][bj][m][1] + xr[m2][bj][1];
#pragma unroll
                    for (int e = 0; e < 4; ++e) ss += v0[e] * v0[e] + v1[e] * v1[e];
                    *(u32x4*)(h1b + off) = pack8(v0, v1); }
                ss += shx(ss, 16, XLANE); ss += shx(ss, 32, XLANE);
                if (fq == 0) h1ss[(size_t)row * 16 + u.pn * 4 + wc] = ss; }
            }
        }
    }
};
struct EpiUp {
    static constexpr bool PERM = true; static constexpr bool FUSE = false; static constexpr bool I8 = false;
    bf16_t* U; const float* h1ss; float* s2v;
    __device__ __forceinline__ void operator()(const f32x4 (&acc)[2][2][4][2], const Unit& u, int wr, int wc, int fr, int fq) const {
        const int cw = u.pn * 256 + wc * 32 + 8 * fq;
        if (u.pn == 0 && wc == 0 && fq == 0) {
            EPI_ROWS_BEGIN const f32x4* sp = (const f32x4*)(h1ss + (size_t)row * 16); const f32x4 a = sp[0], b = sp[1], c = sp[2], d = sp[3];
                const float tot = ((a[0] + a[1]) + (a[2] + a[3])) + ((b[0] + b[1]) + (b[2] + b[3])) + ((c[0] + c[1]) + (c[2] + c[3])) + ((d[0] + d[1]) + (d[2] + d[3]));
                s2v[row] = 1.f / (tot * (1.f / 1024.f) + EPS);
            EPI_ROWS_END
        }
        EPI_ROWS_BEGIN
#pragma unroll
            for (int bj = 0; bj < 2; ++bj) { f32x4 v0 = acc[ai][bj][m][0], v1 = acc[ai][bj][m][1];
#pragma unroll
                for (int e = 0; e < 4; ++e) { const float a = fmaxf(v0[e], 0.f), b = fmaxf(v1[e], 0.f); v0[e] = a * a; v1[e] = b * b; }
                *(u32x4*)(U + (size_t)row * DFF + bj * 128 + cw) = pack8(v0, v1); }
        EPI_ROWS_END
    }
};
struct EpiUp8 {
    static constexpr bool PERM = true; static constexpr bool FUSE = false; static constexpr bool I8 = true;
    bf16_t* U; const float* h1ss; float* s2v; const float* sa; const float* swc;
    __device__ __forceinline__ void operator()(const f32x4 (&acc)[2][2][4][2], const Unit& u, int wr, int wc, int fr, int fq) const {
        const int cw = u.pn * 256 + wc * 32 + 8 * fq;
        if (u.pn == 0 && wc == 0 && fq == 0) {
            EPI_ROWS_BEGIN const f32x4* sp = (const f32x4*)(h1ss + (size_t)row * 16); const f32x4 a = sp[0], b = sp[1], c = sp[2], d = sp[3];
                const float tot = ((a[0] + a[1]) + (a[2] + a[3])) + ((b[0] + b[1]) + (b[2] + b[3])) + ((c[0] + c[1]) + (c[2] + c[3])) + ((d[0] + d[1]) + (d[2] + d[3]));
                s2v[row] = 1.f / (tot * (1.f / 1024.f) + EPS);
            EPI_ROWS_END
        }
        f32x4 swv[2][2];
#pragma unroll
        for (int bj = 0; bj < 2; ++bj) { swv[bj][0] = *(const f32x4*)(swc + bj * 128 + cw); swv[bj][1] = *(const f32x4*)(swc + bj * 128 + cw + 4); }
        EPI_ROWS_BEGIN const float rs = sa[row];
#pragma unroll
            for (int bj = 0; bj < 2; ++bj) { const i32x4_t a0 = __builtin_bit_cast(i32x4_t, acc[ai][bj][m][0]), a1 = __builtin_bit_cast(i32x4_t, acc[ai][bj][m][1]); f32x4 v0, v1;
#pragma unroll
                for (int e = 0; e < 4; ++e) { const float a = fmaxf((float)a0[e] * rs * swv[bj][0][e], 0.f), b = fmaxf((float)a1[e] * rs * swv[bj][1][e], 0.f); v0[e] = a * a; v1[e] = b * b; }
                *(u32x4*)(U + (size_t)row * DFF + bj * 128 + cw) = pack8(v0, v1); }
        EPI_ROWS_END
    }
};
constexpr int CW_PANEL = 16384;
struct EpiDownNorm {
    static constexpr bool PERM = true; static constexpr bool FUSE = false; static constexpr bool I8 = false;
    float* out; const bf16_t* h1b; const float* s2v; const float* fw; unsigned* xch; unsigned* cnt; LAS uchar* lds;
    __device__ __forceinline__ void operator()(f32x4 (&acc)[2][2][4][2], const Unit& u, int wr, int wc, int fr, int fq) const {
        const int cw = u.pn * 256 + wc * 32 + 8 * fq; const int wid = wr * 4 + wc, tid = wid * 64 + fq * 16 + fr;
        LAS float* P = (LAS float*)lds;
        LAS float* Sc = (LAS float*)(lds + 4096);
#pragma unroll
        for (int ai = 0; ai < 2; ++ai) {
            u32x4 hr[4][2]; float s2r[4];
#pragma unroll
            for (int m = 0; m < 4; ++m) { const int row = u.pm * 256 + ai * 128 + wr * 64 + m * 16 + fr; s2r[m] = s2v[row];
#pragma unroll
                for (int bj = 0; bj < 2; ++bj) hr[m][bj] = *(const u32x4*)(h1b + (size_t)row * 1024 + bj * 128 + cw); }
#pragma unroll
            for (int m = 0; m < 4; ++m) {
                const float s2 = s2r[m]; float ss = 0.f;
#pragma unroll
                for (int bj = 0; bj < 2; ++bj) { const u32x4 r = hr[m][bj];
                    f32x4 o0 = acc[ai][bj][m][0] * s2, o1 = acc[ai][bj][m][1] * s2;
                    o0[0] += bf_lo(r.x); o0[1] += bf_hi(r.x); o0[2] += bf_lo(r.y); o0[3] += bf_hi(r.y); o1[0] += bf_lo(r.z); o1[1] += bf_hi(r.z); o1[2] += bf_lo(r.w); o1[3] += bf_hi(r.w);
#pragma unroll
                    for (int e = 0; e < 4; ++e) ss += o0[e] * o0[e] + o1[e] * o1[e];
                    acc[ai][bj][m][0] = o0; acc[ai][bj][m][1] = o1; }
                ss += shx(ss, 16, XLANE); ss += shx(ss, 32, XLANE);
                if (fq == 0) P[(ai * 128 + wr * 64 + m * 16 + fr) * 4 + wc] = ss; }
        }
        asm volatile("s_waitcnt lgkmcnt(0)" ::: "memory"); __builtin_amdgcn_s_barrier(); asm volatile("" ::: "memory");
        unsigned* slot = xch + ((size_t)u.pm * 4 + u.pn) * 256; unsigned* pc = cnt + 64 * u.pm;
        if (tid < 256) { const f32x4 p4 = *(const LAS f32x4*)(P + tid * 4); __hip_atomic_store(slot + tid, __float_as_uint((p4[0] + p4[1]) + (p4[2] + p4[3])), __ATOMIC_RELAXED, __HIP_MEMORY_SCOPE_AGENT); }
        asm volatile("s_waitcnt vmcnt(0)" ::: "memory");
        __builtin_amdgcn_s_barrier(); asm volatile("" ::: "memory");
        if (tid == 0) __hip_atomic_fetch_add(pc, 1u, __ATOMIC_RELAXED, __HIP_MEMORY_SCOPE_AGENT);
        if (wid == 0) { unsigned sp = 0u;
            while ((unsigned)__builtin_amdgcn_readfirstlane(__hip_atomic_load(pc, __ATOMIC_RELAXED, __HIP_MEMORY_SCOPE_AGENT)) < 4u) { __builtin_amdgcn_s_sleep(2); if (++sp > (1u << 22)) break; }
            __builtin_amdgcn_fence(__ATOMIC_ACQUIRE, "agent"); asm volatile("s_waitcnt vmcnt(0)" ::: "memory"); }
        __builtin_amdgcn_s_barrier(); asm volatile("" ::: "memory");
        if (tid < 256) { const unsigned* s0 = xch + (size_t)u.pm * 4 * 256 + tid; float tt = 0.f;
#pragma unroll
            for (int q = 0; q < 4; ++q) tt += __uint_as_float(__hip_atomic_load(s0 + q * 256, __ATOMIC_RELAXED, __HIP_MEMORY_SCOPE_AGENT));
            Sc[tid] = rsqrtf(tt * (1.f / 1024.f) + EPS); }
        asm volatile("s_waitcnt vmcnt(0) lgkmcnt(0)" ::: "memory"); __builtin_amdgcn_s_barrier(); asm volatile("" ::: "memory");
        EPI_ROWS_BEGIN const float rn = Sc[ai * 128 + wr * 64 + m * 16 + fr];
#pragma unroll
            for (int bj = 0; bj < 2; ++bj) { const int col = bj * 128 + cw; const f32x4 w0 = *(const f32x4*)(fw + col), w1 = *(const f32x4*)(fw + col + 4);
                float* p = out + (size_t)row * 1024 + col; *(f32x4*)p = acc[ai][bj][m][0] * rn * w0; *(f32x4*)(p + 4) = acc[ai][bj][m][1] * rn * w1; }
        EPI_ROWS_END
        asm volatile("s_waitcnt lgkmcnt(0)" ::: "memory"); __builtin_amdgcn_s_barrier(); asm volatile("" ::: "memory");
    }
};

#define XB_TMO      128
#define XB_XCNT(j)  (256  + 64 * (j))
#define XB_XSUB(j)  (1280 + 64 * (j))
#define XB_XGEN(j)  (2304 + 64 * (j))
#define XB_TOP      3328
#define XB_TOPGEN   3392
#define XCD_BAR_WORDS 3456
#define XB_SPIN_CAP (1u << 22)
__device__ __forceinline__ unsigned xb_ld(unsigned* p)              { return __hip_atomic_load(p, __ATOMIC_RELAXED, __HIP_MEMORY_SCOPE_AGENT); }
__device__ __forceinline__ unsigned xb_add(unsigned* p, unsigned v) { return __hip_atomic_fetch_add(p, v, __ATOMIC_RELAXED, __HIP_MEMORY_SCOPE_AGENT); }
__device__ __forceinline__ unsigned xb_xcc_id() { return (unsigned)__builtin_amdgcn_s_getreg((3 << 11) | 20) & 0xFu; }
#define XB_SPIN(cond, bar) do { unsigned _sp = 0; while (cond) { __builtin_amdgcn_s_sleep(1); \
    if ((++_sp & 255u) == 0u) { if (xb_ld(&(bar)[XB_TMO])) break; if (_sp > XB_SPIN_CAP) { atomicAdd(&(bar)[XB_TMO], 1u); break; } } } } while (0)
struct XcdBarrier { unsigned* bar; unsigned x; volatile LAS unsigned* st; };
__device__ __forceinline__ XcdBarrier xcd_barrier_post(unsigned* bar, volatile LAS unsigned* st) {
    XcdBarrier b; b.bar = bar; b.x = xb_xcc_id(); b.st = st;
    if (threadIdx.x == 0) { st[4] = xb_add(&bar[XB_XCNT(b.x)], 1u); st[5] = b.x; }
    return b;
}
__device__ __forceinline__ void xcd_barrier_complete(unsigned* bar, unsigned x, unsigned& nloc, unsigned& nx, unsigned& even32) {
    const unsigned G = gridDim.x * gridDim.y * gridDim.z;
    unsigned sum, cnt, mine, ok, sp = 0u;
    for (;;) {
        sum = 0u; cnt = 0u; mine = 0u; ok = 1u;
#pragma unroll
        for (unsigned j = 0; j < 16; ++j) { const unsigned c = xb_ld(&bar[XB_XCNT(j)]); sum += c; cnt += (c > 0u) ? 1u : 0u; mine = (j == x) ? c : mine; ok &= (c == (j < 8u ? 32u : 0u)) ? 1u : 0u; }
        if (sum == G) break;
        __builtin_amdgcn_s_sleep(1);
        if ((++sp & 255u) == 0u) { if (xb_ld(&bar[XB_TMO])) break; if (sp > XB_SPIN_CAP) { atomicAdd(&bar[XB_TMO], 1u); break; } }
    }
    nloc = mine > 0u ? mine : 1u; nx = cnt > 0u ? cnt : 1u; even32 = (sum == G && G == 256u) ? ok : 0u;
}
__device__ __forceinline__ void xcd_barrier(const XcdBarrier& b, int wave, bool local = false) {
    asm volatile("s_waitcnt vmcnt(0)" ::: "memory");
    __syncthreads();
    if (wave == 0 && fresh_lane() == 0) {
        unsigned* bar = b.bar;
        __builtin_amdgcn_s_waitcnt(0);
        unsigned nloc = b.st[0], nx = b.st[1];
        if (nloc == 0u) { unsigned e32; xcd_barrier_complete(bar, b.x, nloc, nx, e32); b.st[0] = nloc; b.st[1] = nx; b.st[2] = e32; }
        const unsigned old = xb_add(&bar[XB_XSUB(b.x)], 1u);
        const unsigned gen = old / nloc;
        if (old + 1u == (gen + 1u) * nloc) {
            if (!local) {
            __builtin_amdgcn_fence(__ATOMIC_RELEASE, "agent");
            asm volatile("s_waitcnt vmcnt(0)" ::: "memory");
            const unsigned og = xb_add(&bar[XB_TOP], 1u);
            const unsigned tg = og / nx;
            if (og + 1u == (tg + 1u) * nx) xb_add(&bar[XB_TOPGEN], 1u);
            else XB_SPIN(xb_ld(&bar[XB_TOPGEN]) == tg, bar);
            }
            __builtin_amdgcn_fence(__ATOMIC_ACQUIRE, "agent");
            xb_add(&bar[XB_XGEN(b.x)], 1u);
            asm volatile("s_waitcnt vmcnt(0)" ::: "memory");
        } else {
            XB_SPIN(xb_ld(&bar[XB_XGEN(b.x)]) == gen, bar);
            __builtin_amdgcn_fence(__ATOMIC_ACQUIRE, "agent");
            asm volatile("s_waitcnt vmcnt(0)" ::: "memory");
        }
    }
    __syncthreads();
}

struct Args { const float* in[24]; float* out; uchar* ws; };
struct Frame {
    LAS uchar* lds; int wave, G, c, vcu;
    const float* const* in; float* out; uchar* ws;
};
__device__ __forceinline__ float wave_sum(float v, int lane) {
#pragma unroll
    for (int o = 1; o < 64; o <<= 1) v += shx(v, o, lane);
    return v;
}

__device__ __forceinline__ void p0_tr_item(const float* src, int ldsrc, int scol0, int nvalid, const float* kscale, bf16_t* dst, int ldd, int dcol0, int n0, int k0, LAS float* scr, int lane) {
    float tv[32]; const int nn = lane & 31, nc = nn < nvalid ? nn : 0;
#pragma unroll
    for (int i = 0; i < 32; ++i) tv[i] = __builtin_nontemporal_load(src + (size_t)(k0 + 2 * i + (lane >> 5)) * ldsrc + scol0 + nc);
#pragma unroll
    for (int i = 0; i < 32; ++i) { const int kk = 2 * i + (lane >> 5); float v = nn < nvalid ? tv[i] : 0.f; if (kscale) v *= kscale[k0 + kk];
        scr[kk * 33 + nn] = v; }
    LDS_WAIT(); asm volatile("" ::: "memory");
    const int c = lane & 7;
#pragma unroll
    for (int j = 0; j < 4; ++j) { const int n = (lane >> 3) + 8 * j; const LAS float* s = scr + (8 * c) * 33 + n;
        u32x4 o; o.x = cvt_pk_bf16(s[0 * 33], s[1 * 33]); o.y = cvt_pk_bf16(s[2 * 33], s[3 * 33]); o.z = cvt_pk_bf16(s[4 * 33], s[5 * 33]); o.w = cvt_pk_bf16(s[6 * 33], s[7 * 33]);
        *(u32x4*)(dst + (size_t)(n0 + n) * ldd + dcol0 + k0 + 8 * c) = o; }
    LDS_WAIT(); asm volatile("" ::: "memory");
}
__device__ __forceinline__ void p0_colmax_item(const float* src, int ldsrc, int scol0, const float* kscale, unsigned* colmax, int k0, int lane) {
    float tv[32]; const int nn = lane & 31;
#pragma unroll
    for (int i = 0; i < 32; ++i) tv[i] = src[(size_t)(k0 + 2 * i + (lane >> 5)) * ldsrc + scol0 + nn];
    float m = 0.f;
#pragma unroll
    for (int i = 0; i < 32; ++i) m = fmaxf(m, fabsf(tv[i] * kscale[k0 + 2 * i + (lane >> 5)]));
    m = fmaxf(m, shx(m, 32, lane));
    if (lane < 32) __hip_atomic_fetch_max(colmax + nn, __float_as_uint(m), __ATOMIC_RELAXED, __HIP_MEMORY_SCOPE_AGENT);
}
__device__ __forceinline__ void p1_w8_task(Frame& F, const float* src, int ldsrc, int scol0, const float* kscale, uchar* W8, float* SW) {
    const int lane = fresh_lane(), nn = lane & 31, hi = lane >> 5, w = F.wave;
    LAS float* scr = (LAS float*)(F.lds + w * 16384);
    LAS float* cmx = (LAS float*)(F.lds + 131072 + 4096);
    float tv[2][32];
#pragma unroll
    for (int sb = 0; sb < 2; ++sb) { const float* p = src + (size_t)(128 * w + 64 * sb + hi) * ldsrc + scol0 + nn;
#pragma unroll
        for (int i = 0; i < 32; ++i) tv[sb][i] = __builtin_nontemporal_load(p + (size_t)(2 * i) * ldsrc); }
    float m = 0.f;
#pragma unroll
    for (int sb = 0; sb < 2; ++sb)
#pragma unroll
        for (int i = 0; i < 32; ++i) { tv[sb][i] *= kscale[128 * w + 64 * sb + 2 * i + hi]; m = fmaxf(m, fabsf(tv[sb][i])); }
    m = fmaxf(m, shx(m, 32, lane));
    if (lane < 32) cmx[w * 32 + nn] = m;
    __syncthreads();
    float cm = 0.f;
#pragma unroll
    for (int j = 0; j < 8; ++j) cm = fmaxf(cm, cmx[j * 32 + nn]);
    const float inv = cm > 0.f ? 127.f / cm : 0.f;
#pragma unroll
    for (int sb = 0; sb < 2; ++sb) { const int k0 = 128 * w + 64 * sb;
#pragma unroll
        for (int i = 0; i < 32; ++i) scr[(2 * i + hi) * 33 + nn] = rintf(tv[sb][i] * inv);
        LDS_WAIT(); asm volatile("" ::: "memory");
        const int c = lane & 7;
#pragma unroll
        for (int j = 0; j < 4; ++j) { const int n = (lane >> 3) + 8 * j; const LAS float* sp = scr + (8 * c) * 33 + n; unsigned bq[8];
#pragma unroll
            for (int e = 0; e < 8; ++e) bq[e] = (unsigned)((int)sp[e * 33]) & 255u;
            u32x2 o; o.x = bq[0] | (bq[1] << 8) | (bq[2] << 16) | (bq[3] << 24); o.y = bq[4] | (bq[5] << 8) | (bq[6] << 16) | (bq[7] << 24);
            *(u32x2*)(W8 + (size_t)n * 1024 + k0 + 8 * c) = o; }
        LDS_WAIT(); asm volatile("" ::: "memory"); }
    if (w == 0 && lane < 32) SW[nn] = cm * (1.f / 127.f);
    __syncthreads();
}
__device__ __forceinline__ void p1_w8_half(Frame& F, const float* src, int ldsrc, int scol0, const float* kscale, uchar* W8, float* SW) {
    const int lane = fresh_lane(), nn = lane & 15, kq = lane >> 4, w = F.wave;
    LAS float* scr = (LAS float*)(F.lds + w * 16384);
    LAS float* cmx = (LAS float*)(F.lds + 131072 + 4096);
    float tv[32];
    { const float* p = src + (size_t)(128 * w + kq) * ldsrc + scol0 + nn;
#pragma unroll
      for (int i = 0; i < 32; ++i) tv[i] = __builtin_nontemporal_load(p + (size_t)(4 * i) * ldsrc); }
    float m = 0.f;
#pragma unroll
    for (int i = 0; i < 32; ++i) { tv[i] *= kscale[128 * w + 4 * i + kq]; m = fmaxf(m, fabsf(tv[i])); }
    m = fmaxf(m, shx(m, 16, lane)); m = fmaxf(m, shx(m, 32, lane));
    if (lane < 16) cmx[w * 32 + nn] = m;
    __syncthreads();
    float cm = 0.f;
#pragma unroll
    for (int j = 0; j < 8; ++j) cm = fmaxf(cm, cmx[j * 32 + nn]);
    const float inv = cm > 0.f ? 127.f / cm : 0.f;
#pragma unroll
    for (int i = 0; i < 32; ++i) scr[(4 * i + kq) * 17 + nn] = rintf(tv[i] * inv);
    LDS_WAIT(); asm volatile("" ::: "memory");
    { const int n = lane >> 2, c = lane & 3; const LAS float* sp = scr + (32 * c) * 17 + n; unsigned wq[8];
#pragma unroll
      for (int d = 0; d < 8; ++d) { unsigned v = 0u;
#pragma unroll
          for (int e = 0; e < 4; ++e) v |= ((unsigned)((int)sp[(4 * d + e) * 17]) & 255u) << (8 * e);
          wq[d] = v; }
      uchar* o = W8 + (size_t)n * 1024 + 128 * w + 32 * c;
      *(u32x4*)o = (u32x4){wq[0], wq[1], wq[2], wq[3]}; *(u32x4*)(o + 16) = (u32x4){wq[4], wq[5], wq[6], wq[7]}; }
    LDS_WAIT(); asm volatile("" ::: "memory");
    if (w == 0 && lane < 16) SW[nn] = cm * (1.f / 127.f);
    __syncthreads();
}
__device__ __forceinline__ void p1_w8_block(Frame& F, int t, int half) {
    uchar* ws = F.ws; const float* src; const float* ks; uchar* W8; float* SW; int ld, sc;
    if (t < 96) { src = F.in[3]; ld = 6120; sc = 3048 + 32 * t; ks = F.in[2]; W8 = ws + WS_W8 + (size_t)(32 * t) * 1024; SW = (float*)(ws + WS_SW) + 32 * t; }
    else if (t < 224) { const int b = t - 96; src = F.in[21]; ld = 4096; sc = 32 * b; ks = F.in[20]; W8 = ws + WS_WUP + (size_t)(32 * b) * 1024; SW = (float*)(ws + WS_SWU) + 32 * b; }
    else if (t < 288) { const int b = t - 224; src = F.in[3]; ld = 6120; sc = 32 * b; ks = F.in[2]; W8 = ws + WS_W8P + (size_t)(32 * b) * 1024; SW = (float*)(ws + WS_SWP) + 32 * b; }
    else { const int b = t - 288; src = F.in[3]; ld = 6120; sc = 2536 + 32 * b; ks = F.in[2]; W8 = ws + WS_W8P + (size_t)(2560 + 32 * b) * 1024; SW = (float*)(ws + WS_SWP) + 2560 + 32 * b; }
    if (half < 0) p1_w8_task(F, src, ld, sc, ks, W8, SW);
    else p1_w8_half(F, src, ld, sc + 16 * half, ks, W8 + (size_t)(16 * half) * 1024, SW + 16 * half);
}
__device__ __forceinline__ void p1_w8_all(Frame& F) {
    if (F.G == 256) { p1_w8_block(F, F.c, -1); if (F.c < 96) p1_w8_block(F, 256 + (F.c >> 1), F.c & 1); }
    else for (int t = F.c; t < 304; t += F.G) p1_w8_block(F, t, -1);
}
template <bool NT = false>
__device__ __forceinline__ void p2_xq_rows(Frame& F, const uchar* srcb, uchar* dstb, int dstride, int row0, int nrows, int wv, int nwv) {
    uchar* ws = F.ws; const int lane = fresh_lane(); float* SXQ = (float*)(ws + WS_SXQ);
    for (int r = row0 + 4 * wv; r < row0 + nrows; r += 4 * nwv) {
        u32x4 lo[4], hi[4]; float am[4];
#pragma unroll
        for (int q = 0; q < 4; ++q) { const u32x4* p = (const u32x4*)(srcb + (size_t)(r + q) * 2048) + 2 * lane; if constexpr (NT) { lo[q] = __builtin_nontemporal_load(p); hi[q] = __builtin_nontemporal_load(p + 1); } else { lo[q] = p[0]; hi[q] = p[1]; } }
#pragma unroll
        for (int q = 0; q < 4; ++q) { const unsigned wd[8] = {lo[q].x, lo[q].y, lo[q].z, lo[q].w, hi[q].x, hi[q].y, hi[q].z, hi[q].w}; float m = 0.f;
#pragma unroll
            for (int e = 0; e < 8; ++e) m = fmaxf(m, fmaxf(fabsf(bf_lo(wd[e])), fabsf(bf_hi(wd[e]))));
            am[q] = m; }
#pragma unroll
        for (int o = 1; o < 64; o <<= 1) { const float t0 = shx(am[0], o, lane), t1 = shx(am[1], o, lane), t2 = shx(am[2], o, lane), t3 = shx(am[3], o, lane); am[0] = fmaxf(am[0], t0); am[1] = fmaxf(am[1], t1); am[2] = fmaxf(am[2], t2); am[3] = fmaxf(am[3], t3); }
#pragma unroll
        for (int q = 0; q < 4; ++q) { const float inv = am[q] > 0.f ? 127.f / am[q] : 0.f; const unsigned wd[8] = {lo[q].x, lo[q].y, lo[q].z, lo[q].w, hi[q].x, hi[q].y, hi[q].z, hi[q].w}; unsigned ow[4];
#pragma unroll
            for (int e = 0; e < 4; ++e) { const unsigned b0 = (unsigned)((int)rintf(bf_lo(wd[2 * e]) * inv)) & 255u, b1 = (unsigned)((int)rintf(bf_hi(wd[2 * e]) * inv)) & 255u, b2 = (unsigned)((int)rintf(bf_lo(wd[2 * e + 1]) * inv)) & 255u, b3 = (unsigned)((int)rintf(bf_hi(wd[2 * e + 1]) * inv)) & 255u;
                ow[e] = b0 | (b1 << 8) | (b2 << 16) | (b3 << 24); }
            *((u32x4*)(dstb + (size_t)(r + q) * dstride) + lane) = (u32x4){ow[0], ow[1], ow[2], ow[3]};
            if (lane == 0) SXQ[r + q] = am[q] * (1.f / 127.f); }
    }
}
__device__ __forceinline__ void p0_row2(const float* x0, const float* x1, bf16_t* o0, bf16_t* o1, float* rs0, float* rs1, int lane) {
    const f32x4* xa = (const f32x4*)x0 + lane; const f32x4* xb = (const f32x4*)x1 + lane; f32x4 va[4], vb[4];
#pragma unroll
    for (int j = 0; j < 4; ++j) va[j] = xa[64 * j];
#pragma unroll
    for (int j = 0; j < 4; ++j) vb[j] = xb[64 * j];
    float sa = 0.f, sb = 0.f;
#pragma unroll
    for (int j = 0; j < 4; ++j) { sa += (va[j][0] * va[j][0] + va[j][1] * va[j][1]) + (va[j][2] * va[j][2] + va[j][3] * va[j][3]); sb += (vb[j][0] * vb[j][0] + vb[j][1] * vb[j][1]) + (vb[j][2] * vb[j][2] + vb[j][3] * vb[j][3]); }
    u32x2* pa = (u32x2*)o0 + lane; u32x2* pb = (u32x2*)o1 + lane;
#pragma unroll
    for (int j = 0; j < 4; ++j) { u32x2 w; w.x = cvt_pk_bf16(va[j][0], va[j][1]); w.y = cvt_pk_bf16(va[j][2], va[j][3]); pa[64 * j] = w; w.x = cvt_pk_bf16(vb[j][0], vb[j][1]); w.y = cvt_pk_bf16(vb[j][2], vb[j][3]); pb[64 * j] = w; }
    sa = wave_sum(sa, lane); sb = wave_sum(sb, lane);
    if (lane == 0) { *rs0 = rsqrtf(sa * (1.f / 1024.f) + EPS); *rs1 = rsqrtf(sb * (1.f / 1024.f) + EPS); }
}

__device__ __forceinline__ void p0_rows4(const float* src, bf16_t* dst, float* rs, int m0, int mstep, int mend, int lane) {
    if (m0 >= mend) return;
    f32x4 va[16], vb[16];
#define P0_LD(v, m) do { const f32x4* p_ = (const f32x4*)(src + (size_t)(m) * 1024) + lane; _Pragma("unroll") for (int j = 0; j < 16; ++j) v[j] = __builtin_nontemporal_load(p_ + 64 * j); } while (0)
#define P0_DO(v, m) do { _Pragma("unroll") for (int r = 0; r < 4; ++r) { float sa = 0.f; u32x2* po = (u32x2*)(dst + (size_t)((m) + r) * 1024) + lane; \
        _Pragma("unroll") for (int j = 0; j < 4; ++j) { const f32x4 x = v[4 * r + j]; sa += (x[0] * x[0] + x[1] * x[1]) + (x[2] * x[2] + x[3] * x[3]); u32x2 w; w.x = cvt_pk_bf16(x[0], x[1]); w.y = cvt_pk_bf16(x[2], x[3]); po[64 * j] = w; } \
        sa = wave_sum(sa, lane); if (lane == 0) rs[(m) + r] = rsqrtf(sa * (1.f / 1024.f) + EPS); } } while (0)
    int m = m0; P0_LD(va, m);
    for (;;) {
        int mn = m + mstep; bool more = mn < mend; P0_LD(vb, more ? mn : m);
        P0_DO(va, m); if (!more) break; m = mn;
        mn = m + mstep; more = mn < mend; P0_LD(va, more ? mn : m);
        P0_DO(vb, m); if (!more) break; m = mn;
    }
#undef P0_LD
#undef P0_DO
}

__device__ __forceinline__ void p0_prologue(Frame& F) {
    const float* const* in = F.in; uchar* ws = F.ws;
    LAS float* scr = (LAS float*)(F.lds + F.wave * 16384);
    const int lane = fresh_lane(), tid_ = F.wave * 64 + lane;
    constexpr int TW = P0_TW;
    const bool rowrole = F.wave >= TW;
    const int gw = rowrole ? F.vcu * (8 - TW) + (F.wave - TW) : F.vcu * TW + F.wave, NGW = rowrole ? F.G * (8 - TW) : F.G * TW;
    bf16_t* Win = (bf16_t*)(ws + WS_WIN); bf16_t* Wkv = (bf16_t*)(ws + WS_WKV); bf16_t* Ball = (bf16_t*)(ws + WS_BALL); bf16_t* Wout = (bf16_t*)(ws + WS_WOUT);
    bf16_t* Wup = (bf16_t*)(ws + WS_WUP); bf16_t* Wdown = (bf16_t*)(ws + WS_WDOWN); bf16_t* Wdq = (bf16_t*)(ws + WS_WDQ);
    constexpr int I0 = 16 * 16, I1 = 16 * 32, I2 = 8 * 32, I3 = 8 * 32, I3b = 8 * 32, I4 = 16 * 32, I6 = 64 * 32, NIT = I0 + I1 + I2 + I3 + I3b + I4 + I6;
    if (!rowrole) for (int it = gw; it < NIT; it += NGW) {
        int r = it;
        if (r < I0) { const int kb = r / 16, n0 = 2048 + (r % 16) * 32; int sc = n0, nv = 32; if (n0 == 2528) nv = 8;
            p0_tr_item(in[3], 6120, sc, nv, in[2], Win, 1024, 0, n0, kb * 64, scr, lane);
            continue; } r -= I0;
        if (r < I1) { p0_tr_item(in[15], 1024, (r % 32) * 32, 32, in[14], Wkv, 1024, 0, (r % 32) * 32, (r / 32) * 64, scr, lane); continue; } r -= I1;
        if (r < I2) { p0_tr_item(in[16], 1024, (r % 32) * 32, 32, nullptr, Ball, 2048, 0, (r % 32) * 32, (r / 32) * 64, scr, lane); continue; } r -= I2;
        if (r < I3) { p0_tr_item(in[18], 1024, (r % 32) * 32, 32, nullptr, Ball, 2048, 1536, (r % 32) * 32, (r / 32) * 64, scr, lane); continue; } r -= I3;
        if (r < I3b) { p0_tr_item(in[17], 1024, (r % 32) * 32, 32, nullptr, Ball, 2048, 512, (r % 32) * 32, (r / 32) * 64, scr, lane); continue; } r -= I3b;
        if (r < I4) { p0_tr_item(in[19], 1024, (r % 32) * 32, 32, nullptr, Wout, 1024, 0, (r % 32) * 32, (r / 32) * 64, scr, lane); continue; } r -= I4;
        p0_tr_item(in[22], 1024, (r % 32) * 32, 32, nullptr, Wdown, 4096, 0, (r % 32) * 32, (r / 32) * 64, scr, lane);
    }
    if (rowrole) { p0_rows4(in[0], (bf16_t*)(ws + WS_XB), (float*)(ws + WS_RSX), 4 * gw, 4 * NGW, MTOK, lane); p0_rows4(in[1], (bf16_t*)(ws + WS_MB), (float*)(ws + WS_RSM), 4 * gw, 4 * NGW, MMEM, lane); }
    if (rowrole) return;
    const int gt = F.vcu * (TW * 64) + tid_, NGT = F.G * (TW * 64);
    const float* w_uq = in[9]; const float* w_qr = in[10]; const float* w_uk = in[11]; const float* w_uv = in[12]; const float* w_qidx = in[13]; const float* qnw = in[6];
    const float SCL = 0.10206207261596577f * LOG2E;
    for (int e = gt; e < 1792 * 256; e += NGT) {
        const int row = e >> 8, c = e & 255; float v;
        if (row < 1024) { const int h = row >> 7, j = row & 127; float s = 0.f; const float* a = w_uq + (size_t)c * 512 + h * 64; const float* b = w_uk + (size_t)h * 64 * 128 + j;
#pragma unroll 8
            for (int n = 0; n < 64; ++n) s += a[n] * b[n * 128];
            v = s * SCL; }
        else if (row < 1280) { const int r = row - 1024, h = r >> 5, p = r & 31, d = (p >> 1) + 16 * (p & 1); v = w_qr[(size_t)c * 256 + h * 32 + d] * SCL; }
        else { const int r = row - 1280, h = r >> 6, p = r & 63, d = (p >> 1) + 32 * (p & 1); v = w_qidx[(size_t)c * 512 + h * 64 + d]; }
        v *= qnw[c];
        const float o = shdn(v, 1, lane); if ((e & 1) == 0) *(unsigned*)(Wdq + e) = cvt_pk_bf16(v, o);
    }
    { bf16_t* wuvt = (bf16_t*)(ws + WS_WUVT);
      for (int e = gt; e < 8 * 64 * 128; e += NGT) { const int h = e >> 13, v = (e >> 7) & 63, c = e & 127; const float x = w_uv[(size_t)h * 8192 + c * 64 + v];
          const float o = shdn(x, 1, lane); if ((e & 1) == 0) *(unsigned*)(wuvt + e) = cvt_pk_bf16(x, o); } }
    float* tab32 = (float*)(ws + WS_TAB32); float* tab64 = (float*)(ws + WS_TAB64);
    for (int e = gt; e < 2048 * 16; e += NGT) { const int t = e >> 4, i = e & 15; const float inv = powf(10000.f, -(float)(2 * i) / 32.f); float s, c; sincosf((float)t * inv, &s, &c); tab32[2 * e] = c; tab32[2 * e + 1] = s; }
    for (int e = gt; e < 2048 * 32; e += NGT) { const int t = e >> 5, i = e & 31; const float inv = powf(10000.f, -(float)(2 * i) / 64.f); float s, c; sincosf((float)t * inv, &s, &c); tab64[2 * e] = c; tab64[2 * e + 1] = s; }
    if (gt < 512) { const float a0 = in[4][gt], a1 = in[4][512 + gt]; ((float*)(ws + WS_LB))[gt] = 1.f / (1.f + expf(a1 - a0)); }
}

__device__ __forceinline__ void kv_prep_grp(Frame& F, int grp, int lane) {
    uchar* ws = F.ws; const int row0 = grp * 8; const int b = row0 >> 11, t0 = row0 & (SEQ - 1);
    const f32x2 wk = *(const f32x2*)(F.in[7] + 2 * lane);
#pragma unroll
    for (int j = 0; j < 8; ++j) {
        const int row = row0 + j, t = t0 + j; const float* r9 = (const float*)(ws + WS_R9) + (size_t)(row >> 12) * XS_R9 + (size_t)row * 256;
        bf16_t* kv = (bf16_t*)(ws + WS_KV) + (size_t)(row >> 12) * XS_KV + (size_t)row * 160; bf16_t* kidx = (bf16_t*)(ws + WS_KIDX) + (size_t)(row >> 12) * XS_KIDX + (size_t)row * 64;
        const f32x2 a = *(const f32x2*)(r9 + 2 * lane); const float ss = wave_sum(a[0] * a[0] + a[1] * a[1], lane); const float rn = rsqrtf(ss * (1.f / 128.f) + EPS);
        const unsigned pk = cvt_pk_bf16(a[0] * rn * wk[0], a[1] * rn * wk[1]);
        *(unsigned*)(kv + 2 * lane) = pk;
        if (lane < 16) { const float x0 = r9[128 + lane], x1 = r9[144 + lane]; const f32x2 cs = *(const f32x2*)((const float*)(ws + WS_TAB32) + ((size_t)t * 16 + lane) * 2);
            *(unsigned*)(kv + 128 + 2 * lane) = cvt_pk_bf16(x0 * cs[0] - x1 * cs[1], x1 * cs[0] + x0 * cs[1]); }
        { const int i = lane & 31; const float x0 = r9[160 + i], x1 = r9[192 + i]; float s2 = x0 * x0 + x1 * x1;
#pragma unroll
          for (int o = 1; o < 32; o <<= 1) s2 += shx(s2, o, lane);
          const float rk = rsqrtf(s2 * (1.f / 64.f) + EPS); const float y0 = x0 * rk * F.in[8][i], y1 = x1 * rk * F.in[8][32 + i];
          const f32x2 cs = *(const f32x2*)((const float*)(ws + WS_TAB64) + ((size_t)t * 32 + i) * 2);
          if (lane < 32) *(unsigned*)(kidx + 2 * i) = cvt_pk_bf16(y0 * cs[0] - y1 * cs[1], y1 * cs[0] + y0 * cs[1]); }
        if (lane < 8) ((float*)(ws + WS_WIDX))[(size_t)row * 8 + lane] = r9[224 + lane] * 0.044194173824159216f;
    }
}

constexpr int HG_QREF = 0, HG_QT = 16384, HG_KV0 = 32768, HG_KHT = 73728, HG_VT = 90112, HG_AM = 106496, HG_ST = 114688, HG_TOT = 147456, HG_DV = 151552, HG_SS = 152064;
__device__ __forceinline__ int hg_kv_off(int i) { return HG_KV0 + (i == 0 ? 0 : (i == 1 ? 4096 : (i == 2 ? 12288 : 24576))); }
__device__ __forceinline__ void hgrn_chain(Frame& F, int chain) {
    LAS uchar* L = F.lds; uchar* ws = F.ws;
    const int lane = fresh_lane(), tid = F.wave * 64 + lane;
    const int b = chain >> 2, h = chain & 3, w = F.wave, g = lane >> 4, c16 = lane & 15, kp = lane;
    const int ii = w & 3, half = w >> 2, si = w >> 1;
    const float* Gp = (const float*)(ws + WS_G); const bf16_t* HV = (const bf16_t*)(ws + WS_HV); const bf16_t* SG = HV + 512;
    bf16_t* OALL = (bf16_t*)F.out; constexpr int OSTR = 2048;
    const bf16_t* HQ = (const bf16_t*)(ws + WS_HQ) + (size_t)(b >> 1) * XS_HQ; const float* onw = F.in[5] + h * 128;
    for (int o = tid * 16; o < 32768 + 8192; o += NTHR * 16) *(LAS u32x4*)(L + HG_AM + o) = (u32x4){0u, 0u, 0u, 0u};
    f32x4 S[8];
#pragma unroll
    for (int n = 0; n < 8; ++n) S[n] = (f32x4){0.f, 0.f, 0.f, 0.f};
    f32x2 gq[8]; unsigned qv[8], vv[8];
    const size_t rowbase = (size_t)b * SEQ;
#define HG_LOAD(c) do { _Pragma("unroll") for (int j = 0; j < 8; ++j) { const size_t row = rowbase + 64 * (c) + 8 * w + j; \
        gq[j] = __builtin_nontemporal_load((const f32x2*)(Gp + row * 512 + h * 128 + 2 * kp)); qv[j] = __builtin_nontemporal_load((const unsigned*)(HQ + row * 512 + h * 128 + 2 * kp)); vv[j] = __builtin_nontemporal_load((const unsigned*)(HV + row * 1024 + h * 128 + 2 * kp)); } } while (0)
    HG_LOAD(0);
    __syncthreads();
    for (int c = 0; c < 32; ++c) {
        float c0[8], c1[8]; { float s0 = 0.f, s1 = 0.f;
#pragma unroll
            for (int j = 0; j < 8; ++j) { s0 += gq[j][0]; s1 += gq[j][1]; c0[j] = s0; c1[j] = s1; }
            *(LAS f32x2*)(L + HG_TOT + (w * 128 + 2 * kp) * 4) = (f32x2){s0, s1}; }
        __syncthreads();
        f32x2 pre[9]; pre[0] = (f32x2){0.f, 0.f};
#pragma unroll
        for (int k = 0; k < 8; ++k) { const f32x2 t = *(const LAS f32x2*)(L + HG_TOT + (k * 128 + 2 * kp) * 4); pre[k + 1] = pre[k] + t; }
        f32x2 beta = pre[0], pw = pre[0];
#pragma unroll
        for (int k = 1; k < 8; ++k) { if (2 * si == k) beta = pre[k]; if (w == k) pw = pre[k]; }
        const f32x2 off = pw - beta, blast = pre[8];
        const f32x2 eb = (f32x2){fast_exp(beta[0]), fast_exp(beta[1])};
        const f32x2 fl = (f32x2){fast_exp(blast[0] - beta[0]), fast_exp(blast[1] - beta[1])};
        f32x2 fi[4];
#pragma unroll
        for (int i2 = 0; i2 < 4; ++i2) { const f32x2 d = pre[2 * i2] - beta; fi[i2] = (f32x2){fast_exp(fminf(d[0], 0.f)), fast_exp(fminf(d[1], 0.f))}; }
        if (w == 0) *(LAS f32x2*)(L + HG_DV + 2 * kp * 4) = (f32x2){fast_exp(blast[0]), fast_exp(blast[1])};
        unsigned kh0[4], kh1[4], vt0[4], vt1[4];
#pragma unroll
        for (int j = 0; j < 8; ++j) {
            const float cj0 = off[0] + c0[j], cj1 = off[1] + c1[j];
            const float e0 = fast_exp(cj0), e1 = fast_exp(cj1), ei0 = fast_exp(-cj0), ei1 = fast_exp(-cj1);
            const float k0 = (1.f - fast_exp(gq[j][0])) * ei0, k1 = (1.f - fast_exp(gq[j][1])) * ei1;
            const float q0 = bf_lo(qv[j]) * e0, q1 = bf_hi(qv[j]) * e1;
            const int t = 8 * w + j; const int eo = sw256(t, kp >> 2) + (kp & 3) * 4;
            *(LAS unsigned*)(L + HG_QREF + eo) = cvt_pk_bf16(q0, q1);
            *(LAS unsigned*)(L + HG_QT + eo) = cvt_pk_bf16(q0 * eb[0], q1 * eb[1]);
#pragma unroll
            for (int i2 = 0; i2 < 4; ++i2) if (i2 >= si) *(LAS unsigned*)(L + hg_kv_off(i2) + eo) = cvt_pk_bf16(k0 * fi[i2][0], k1 * fi[i2][1]);
            const float h0 = k0 * fl[0], h1 = k1 * fl[1];
            if (j & 1) { kh0[j >> 1] = cvt_pk_bf16(__uint_as_float(kh0[j >> 1]), h0); kh1[j >> 1] = cvt_pk_bf16(__uint_as_float(kh1[j >> 1]), h1);
                         vt0[j >> 1] = (vt0[j >> 1] & 0xffffu) | (vv[j] << 16); vt1[j >> 1] = (vt1[j >> 1] >> 16) | (vv[j] & 0xffff0000u); }
            else { kh0[j >> 1] = __float_as_uint(h0); kh1[j >> 1] = __float_as_uint(h1); vt0[j >> 1] = vv[j] & 0xffffu; vt1[j >> 1] = vv[j] & 0xffff0000u; }
        }
        *(LAS u32x4*)(L + HG_KHT + sw128(2 * kp, w)) = (u32x4){kh0[0], kh0[1], kh0[2], kh0[3]};
        *(LAS u32x4*)(L + HG_KHT + sw128(2 * kp + 1, w)) = (u32x4){kh1[0], kh1[1], kh1[2], kh1[3]};
        *(LAS u32x4*)(L + HG_VT + sw128(2 * kp, w)) = (u32x4){vt0[0], vt0[1], vt0[2], vt0[3]};
        *(LAS u32x4*)(L + HG_VT + sw128(2 * kp + 1, w)) = (u32x4){vt1[0], vt1[1], vt1[2], vt1[3]};
        __syncthreads();
        { const int cn = c + 1 < 32 ? c + 1 : 31; HG_LOAD(cn); }
        const size_t orow = rowbase + 64 * c + 16 * ii + c16;
        u32x2 sgv[4];
#pragma unroll
        for (int n = 0; n < 4; ++n) sgv[n] = __builtin_nontemporal_load((const u32x2*)(SG + orow * 1024 + h * 128 + 64 * half + 16 * n + 4 * g));
        f32x4 oT[4];
        {
            const int jA = half, jB = half + 2;
            bf16x8 qr[4], kvA[4], kvB[4], qt[4], stf[4][4];
#pragma unroll
            for (int ks = 0; ks < 4; ++ks) { qr[ks] = *(const LAS bf16x8*)(L + HG_QREF + sw256(16 * ii + c16, 4 * ks + g));
                kvA[ks] = *(const LAS bf16x8*)(L + hg_kv_off(ii) + sw256(16 * jA + c16, 4 * ks + g)); kvB[ks] = *(const LAS bf16x8*)(L + hg_kv_off(ii) + sw256(16 * jB + c16, 4 * ks + g));
                qt[ks] = *(const LAS bf16x8*)(L + HG_QT + sw256(16 * ii + c16, 4 * ks + g)); }
            __builtin_amdgcn_sched_barrier(0);
#pragma unroll
            for (int n = 0; n < 2; ++n)
#pragma unroll
                for (int ks = 0; ks < 4; ++ks) stf[n][ks] = *(const LAS bf16x8*)(L + HG_ST + sw256(64 * half + 16 * n + c16, 4 * ks + g));
            f32x4 aA = (f32x4){0.f, 0.f, 0.f, 0.f}, aB = aA;
#pragma unroll
            for (int ks = 0; ks < 4; ++ks) { aA = mma16(kvA[ks], qr[ks], aA); aB = mma16(kvB[ks], qr[ks], aB); }
            __builtin_amdgcn_sched_barrier(0);
#pragma unroll
            for (int n = 2; n < 4; ++n)
#pragma unroll
                for (int ks = 0; ks < 4; ++ks) stf[n][ks] = *(const LAS bf16x8*)(L + HG_ST + sw256(64 * half + 16 * n + c16, 4 * ks + g));
#pragma unroll
            for (int n = 0; n < 2; ++n) { oT[n] = (f32x4){0.f, 0.f, 0.f, 0.f};
#pragma unroll
                for (int ks = 0; ks < 4; ++ks) oT[n] = mma16(stf[n][ks], qt[ks], oT[n]); }
            __builtin_amdgcn_sched_barrier(0);
#pragma unroll
            for (int n = 2; n < 4; ++n) { oT[n] = (f32x4){0.f, 0.f, 0.f, 0.f};
#pragma unroll
                for (int ks = 0; ks < 4; ++ks) oT[n] = mma16(stf[n][ks], qt[ks], oT[n]); }
            if (jA <= ii) { if (jA == ii) {
#pragma unroll
                    for (int r = 0; r < 4; ++r) if (4 * g + r > c16) aA[r] = 0.f; }
                u32x2 pk; pk.x = cvt_pk_bf16(aA[0], aA[1]); pk.y = cvt_pk_bf16(aA[2], aA[3]);
                *(LAS u32x2*)(L + HG_AM + sw128(16 * ii + c16, 2 * jA + (g >> 1)) + (g & 1) * 8) = pk; }
            if (jB <= ii) { if (jB == ii) {
#pragma unroll
                    for (int r = 0; r < 4; ++r) if (4 * g + r > c16) aB[r] = 0.f; }
                u32x2 pk; pk.x = cvt_pk_bf16(aB[0], aB[1]); pk.y = cvt_pk_bf16(aB[2], aB[3]);
                *(LAS u32x2*)(L + HG_AM + sw128(16 * ii + c16, 2 * jB + (g >> 1)) + (g & 1) * 8) = pk; }
        }
        __syncthreads();
        {
            bf16x8 am[2], kh[2], vs[8][2];
#pragma unroll
            for (int ks = 0; ks < 2; ++ks) { am[ks] = *(const LAS bf16x8*)(L + HG_AM + sw128(16 * ii + c16, 4 * ks + g)); kh[ks] = *(const LAS bf16x8*)(L + HG_KHT + sw128(16 * w + c16, 4 * ks + g));
#pragma unroll
                for (int n = 0; n < 8; ++n) vs[n][ks] = *(const LAS bf16x8*)(L + HG_VT + sw128(16 * n + c16, 4 * ks + g)); }
            const f32x4 d4 = *(const LAS f32x4*)(L + HG_DV + (16 * w + 4 * g) * 4);
            __builtin_amdgcn_sched_barrier(0);
#pragma unroll
            for (int ks = 0; ks < 2; ++ks)
#pragma unroll
                for (int n = 0; n < 4; ++n) oT[n] = half ? mma16(vs[4 + n][ks], am[ks], oT[n]) : mma16(vs[n][ks], am[ks], oT[n]);
            { float ss = 0.f;
#pragma unroll
              for (int n = 0; n < 4; ++n) ss += (oT[n][0] * oT[n][0] + oT[n][1] * oT[n][1]) + (oT[n][2] * oT[n][2] + oT[n][3] * oT[n][3]);
              ss += shx(ss, 16, lane); ss += shx(ss, 32, lane);
              if (g == 0) *(LAS float*)(L + HG_SS + (half * 64 + 16 * ii + c16) * 4) = ss; }
#pragma unroll
            for (int n = 0; n < 8; ++n) S[n] = S[n] * d4;
#pragma unroll
            for (int ks = 0; ks < 2; ++ks)
#pragma unroll
                for (int n = 0; n < 8; ++n) S[n] = mma16(kh[ks], vs[n][ks], S[n]);
#pragma unroll
            for (int n = 0; n < 8; ++n) { u32x2 pk; pk.x = cvt_pk_bf16(S[n][0], S[n][1]); pk.y = cvt_pk_bf16(S[n][2], S[n][3]);
                *(LAS u32x2*)(L + HG_ST + sw256(16 * n + c16, 2 * w + (g >> 1)) + (g & 1) * 8) = pk; }
        }
        __syncthreads();
        { const float ss = *(const LAS float*)(L + HG_SS + (16 * ii + c16) * 4) + *(const LAS float*)(L + HG_SS + (64 + 16 * ii + c16) * 4);
          const float rn = rsqrtf(ss * (1.f / 128.f) + EPS);
#pragma unroll
          for (int n = 0; n < 4; ++n) { const int dv0 = 64 * half + 16 * n + 4 * g; const f32x4 wv = *(const f32x4*)(onw + dv0);
              u32x2 pk; pk.x = cvt_pk_bf16(oT[n][0] * rn * wv[0] * bf_lo(sgv[n].x), oT[n][1] * rn * wv[1] * bf_hi(sgv[n].x));
              pk.y = cvt_pk_bf16(oT[n][2] * rn * wv[2] * bf_lo(sgv[n].y), oT[n][3] * rn * wv[3] * bf_hi(sgv[n].y));
              *(u32x2*)(OALL + orow * OSTR + h * 128 + dv0) = pk; } }
    }
#undef HG_LOAD
    __syncthreads();
}

constexpr int KC_STR = 288, KR_STR = 96, VT_STR = 160, PS_STR = 160, QX_STR = 1056;
constexpr int AT_KC = 0, AT_KR = 18432, AT_VT = 24576, AT_BUF = 45056  , AT_PS = 90112, AT_MASK = 131072, AT_EQM = 139520, AT_CNT = 147968;
constexpr int SC_STR = 8208;
constexpr int MK_STR = 66  , HS_STR = 260  ;
template <bool SHARED, bool MASKED>
__device__ __forceinline__ void attn_unit(Frame& F, const bf16_t* qptr, int qstride, bf16_t* optr, int ostride, const bf16_t* qrptr, int qrstride, const bf16_t* kbase, int kstride, const bf16_t* vbase, int vstride, int ntiles, const bf16_t* wuvt = nullptr) {
    constexpr int NKS = SHARED ? 5 : 4;
    const int lane = fresh_lane(), tid = F.wave * 64 + lane;
    LAS uchar* L = F.lds; const int w = F.wave, g = lane >> 4, c16 = lane & 15;
    bf16x8 qf[2][NKS];
#pragma unroll
    for (int mt = 0; mt < 2; ++mt) {
#pragma unroll
        for (int ks = 0; ks < 4; ++ks) qf[mt][ks] = *(const bf16x8*)(qptr + (size_t)(16 * mt + c16) * qstride + 32 * ks + 8 * g);
        if (SHARED) qf[mt][NKS - 1] = *(const bf16x8*)(qrptr + (size_t)(16 * mt + c16) * qrstride + 8 * g);
    }
    constexpr int KNT = SHARED ? 4096 : 16 * KC_STR, KRNT = SHARED ? 1024 : 16 * KR_STR, VCT = SHARED ? 2048 : 16 * VT_STR;
    int kofs[5], vofs[2];
#pragma unroll
    for (int ks = 0; ks < 4; ++ks) kofs[ks] = SHARED ? AT_KC + c16 * 256 + (((4 * ks + g) ^ c16) << 4) : AT_KC + c16 * KC_STR + g * 16 + ks * 64;
    kofs[4] = SHARED ? AT_KR + c16 * 64 + ((g ^ ((0x78 >> (((c16 >> 2) & 3) * 2)) & 3)) << 4) : AT_KR + c16 * KR_STR + g * 16;
#pragma unroll
    for (int hf = 0; hf < 2; ++hf) vofs[hf] = SHARED ? AT_VT + c16 * 128 + (((4 * hf + g) ^ ((c16 >> 1) & 7)) << 4) : AT_VT + c16 * VT_STR + g * 16 + hf * 64;
    LAS uchar* psr = L + AT_PS + w * (32 * PS_STR) + c16 * PS_STR + g * 16; LAS uchar* psw = L + AT_PS + w * (32 * PS_STR) + c16 * PS_STR + g * 8;
    f32x4 O[2][8];
#pragma unroll
    for (int mt = 0; mt < 2; ++mt)
#pragma unroll
        for (int ct = 0; ct < 8; ++ct) O[mt][ct] = (f32x4){0.f, 0.f, 0.f, 0.f};
    float mrow[2] = {-1e30f, -1e30f}, lsum[2] = {0.f, 0.f};
    unsigned dk[2] = {0u, 0u}, dv[2] = {0u, 0u}, dr = 0u;
    if (SHARED) {
#pragma unroll
        for (int q = 0; q < 2; ++q) { const int n = w + 8 * q; const int rk = 4 * n + (lane >> 4), pk = lane & 15; dk[q] = (unsigned)(rk * kstride + 8 * (pk ^ (rk & 15)));
            const int rv = 8 * n + (lane >> 3), pv = lane & 7; dv[q] = (unsigned)(rv * vstride + 8 * (pv ^ ((rv >> 1) & 7))); }
        { const int rr = 16 * (w & 3) + (lane >> 2), pr = lane & 3; dr = (unsigned)(rr * kstride + 128 + 8 * (pr ^ ((0x78 >> (((rr >> 2) & 3) * 2)) & 3))); }
    }
#define AT_DMA(kt, bo) do { _Pragma("unroll") for (int q = 0; q < 2; ++q) { \
        __builtin_amdgcn_global_load_lds((const unsigned*)(kbase + (size_t)(kt) * 64 * kstride + dk[q]), (LAS unsigned*)(L + (bo) + AT_KC + (w + 8 * q) * 1024), 16, 0, 0); \
        __builtin_amdgcn_global_load_lds((const unsigned*)(vbase + (size_t)(kt) * 64 + dv[q]), (LAS unsigned*)(L + (bo) + AT_VT + (w + 8 * q) * 1024), 16, 0, 0); } \
        if (w < 4) __builtin_amdgcn_global_load_lds((const unsigned*)(kbase + (size_t)(kt) * 64 * kstride + dr), (LAS unsigned*)(L + (bo) + AT_KR + w * 1024), 16, 0, 0); } while (0)
    u32x4 st[4]; const bf16_t* gp[4];
    if (!SHARED) {
#pragma unroll
        for (int i = 0; i < 4; ++i) { const int cid = tid + 512 * i; const int key = (cid & 1023) >> 4, ch = cid & 15; gp[i] = (i < 2 ? kbase : vbase) + (size_t)key * (i < 2 ? kstride : vstride) + ch * 8; }
    }
#define AT_FETCH(kt) do { _Pragma("unroll") for (int i = 0; i < 4; ++i) st[i] = *(const u32x4*)(gp[i] + (size_t)(kt) * 64 * (i < 2 ? kstride : vstride)); } while (0)
#define AT_STORE(bo) do { _Pragma("unroll") for (int i = 0; i < 4; ++i) { const int cid = tid + 512 * i; const int key = (cid & 1023) >> 4, ch = cid & 15; \
        if (i < 2) *(LAS u32x4*)(L + (bo) + AT_KC + key * KC_STR + ch * 16) = st[i]; \
        else { const unsigned e4[4] = {st[i].x, st[i].y, st[i].z, st[i].w}; \
            _Pragma("unroll") for (int e = 0; e < 8; ++e) { const int c = 8 * ch + e; *(LAS bf16_t*)(L + (bo) + AT_VT + c * VT_STR + key * 2) = (bf16_t)((e & 1) ? (e4[e >> 1] >> 16) : (e4[e >> 1] & 0xffffu)); } } } } while (0)
    if (!SHARED) AT_FETCH(0);
    __syncthreads();
    if (SHARED) AT_DMA(0, 0); else { AT_STORE(0); if (ntiles > 1) AT_FETCH(1); }
    __syncthreads();
    for (int kt = 0; kt < ntiles; ++kt) {
        const int bo = (kt & 1) * AT_BUF;
        if (kt + 1 < ntiles) { if (SHARED) AT_DMA(kt + 1, AT_BUF - bo); else { AT_STORE(AT_BUF - bo); if (kt + 2 < ntiles) AT_FETCH(kt + 2); } }
#define AT_LDK(dst, nt) do { _Pragma("unroll") for (int ks = 0; ks < 4; ++ks) dst[ks] = *(const LAS bf16x8*)(L + bo + kofs[ks] + (nt) * KNT); \
        if (NKS == 5) dst[NKS - 1] = *(const LAS bf16x8*)(L + bo + kofs[4] + (nt) * KRNT); } while (0)
#define AT_MMK(n, src) do { sT[0][n] = (f32x4){0.f, 0.f, 0.f, 0.f}; sT[1][n] = (f32x4){0.f, 0.f, 0.f, 0.f}; \
        _Pragma("unroll") for (int ks = 0; ks < NKS; ++ks) { sT[0][n] = mma16(src[ks], qf[0][ks], sT[0][n]); sT[1][n] = mma16(src[ks], qf[1][ks], sT[1][n]); } } while (0)
        bf16x8 kA[NKS], kB[NKS];
        AT_LDK(kA, 0); AT_LDK(kB, 1); __builtin_amdgcn_sched_barrier(0);
        u32x2 mw[2] = {(u32x2){0xffffffffu, 0xffffffffu}, (u32x2){0xffffffffu, 0xffffffffu}};
        if (MASKED) { mw[0] = *(const LAS u32x2*)(L + AT_MASK + c16 * (MK_STR * 4) + kt * 8); mw[1] = *(const LAS u32x2*)(L + AT_MASK + (16 + c16) * (MK_STR * 4) + kt * 8); }
#pragma unroll
        for (int hf = 0; hf < 2; ++hf) {
            f32x4 sT[2][2];
            AT_MMK(0, kA); AT_MMK(1, kB);
#pragma unroll
            for (int mt = 0; mt < 2; ++mt) {
                const unsigned mword = hf ? mw[mt].y : mw[mt].x; const unsigned sel[2] = {(mword >> (4 * g)) & 15u, (mword >> (16 + 4 * g)) & 15u};
                float mx = fmaxf(fmaxf(fmaxf(sT[mt][0][0], sT[mt][0][1]), fmaxf(sT[mt][0][2], sT[mt][0][3])), fmaxf(fmaxf(sT[mt][1][0], sT[mt][1][1]), fmaxf(sT[mt][1][2], sT[mt][1][3])));
                if (__any(mx > mrow[mt] + 8.0f)) {
                    mx = fmaxf(mx, shx(mx, 16, lane)); mx = fmaxf(mx, shx(mx, 32, lane));
                    const float mn2 = fmaxf(mrow[mt], mx), alpha = __builtin_amdgcn_exp2f(mrow[mt] - mn2); mrow[mt] = mn2; lsum[mt] *= alpha;
#pragma unroll
                    for (int ct = 0; ct < 8; ++ct) O[mt][ct] = O[mt][ct] * alpha;
                }
                const float mn = mrow[mt]; float ps = 0.f;
#pragma unroll
                for (int n = 0; n < 2; ++n) { f32x4 p;
#pragma unroll
                    for (int r = 0; r < 4; ++r) { const float e = __builtin_amdgcn_exp2f(sT[mt][n][r] - mn);
                        const unsigned m = MASKED ? (unsigned)(((int)(sel[n] << (31 - r))) >> 31) : 0xffffffffu;
                        p[r] = __uint_as_float(__float_as_uint(e) & m); ps += p[r]; }
                    u32x2 pk; pk.x = cvt_pk_bf16(p[0], p[1]); pk.y = cvt_pk_bf16(p[2], p[3]);
                    *(LAS u32x2*)(psw + mt * 16 * PS_STR + (2 * hf + n) * 32) = pk; }
                lsum[mt] += ps;
            }
            LDS_WAIT();
            const bf16x8 p0 = *(const LAS bf16x8*)(psr + hf * 64), p1 = *(const LAS bf16x8*)(psr + 16 * PS_STR + hf * 64);
            bf16x8 vv[8];
#pragma unroll
            for (int ct = 0; ct < 8; ++ct) vv[ct] = *(const LAS bf16x8*)(L + bo + vofs[hf] + ct * VCT);
            if (hf == 0) { AT_LDK(kA, 2); AT_LDK(kB, 3); }
            __builtin_amdgcn_sched_barrier(0);
#pragma unroll
            for (int ct = 0; ct < 8; ++ct) { O[0][ct] = mma16(vv[ct], p0, O[0][ct]); O[1][ct] = mma16(vv[ct], p1, O[1][ct]); }
        }
#undef AT_LDK
#undef AT_MMK
        __syncthreads();
    }
#undef AT_STORE
#undef AT_FETCH
#undef AT_DMA
    float inv[2];
#pragma unroll
    for (int mt = 0; mt < 2; ++mt) { float l = lsum[mt]; l += shx(l, 16, lane); l += shx(l, 32, lane); inv[mt] = 1.f / l; }
    if (wuvt == nullptr) {
#pragma unroll
        for (int mt = 0; mt < 2; ++mt)
#pragma unroll
            for (int ct = 0; ct < 8; ++ct) { u32x2 pk; pk.x = cvt_pk_bf16(O[mt][ct][0] * inv[mt], O[mt][ct][1] * inv[mt]); pk.y = cvt_pk_bf16(O[mt][ct][2] * inv[mt], O[mt][ct][3] * inv[mt]);
                *(u32x2*)(optr + (size_t)(16 * mt + c16) * ostride + 16 * ct + 4 * g) = pk; }
    } else {
        f32x4 ob[2][4];
#pragma unroll
        for (int mt = 0; mt < 2; ++mt)
#pragma unroll
            for (int vt = 0; vt < 4; ++vt) ob[mt][vt] = (f32x4){0.f, 0.f, 0.f, 0.f};
#pragma unroll
        for (int sk = 0; sk < 4; ++sk) {
            bf16x8 bq[2];
#pragma unroll
            for (int mt = 0; mt < 2; ++mt) { const unsigned x0 = cvt_pk_bf16(O[mt][2 * sk][0] * inv[mt], O[mt][2 * sk][1] * inv[mt]), x1 = cvt_pk_bf16(O[mt][2 * sk][2] * inv[mt], O[mt][2 * sk][3] * inv[mt]);
                const unsigned x2 = cvt_pk_bf16(O[mt][2 * sk + 1][0] * inv[mt], O[mt][2 * sk + 1][1] * inv[mt]), x3 = cvt_pk_bf16(O[mt][2 * sk + 1][2] * inv[mt], O[mt][2 * sk + 1][3] * inv[mt]);
                bq[mt] = __builtin_bit_cast(bf16x8, (u32x4){x0, x1, x2, x3}); }
#pragma unroll
            for (int vt = 0; vt < 4; ++vt) { const bf16_t* wp = wuvt + (size_t)(16 * vt + c16) * 128 + 32 * sk + 4 * g;
                const u32x2 a0 = *(const u32x2*)wp, a1 = *(const u32x2*)(wp + 16); const bf16x8 af = __builtin_bit_cast(bf16x8, (u32x4){a0.x, a0.y, a1.x, a1.y});
                ob[0][vt] = mma16(af, bq[0], ob[0][vt]); ob[1][vt] = mma16(af, bq[1], ob[1][vt]); }
        }
#pragma unroll
        for (int mt = 0; mt < 2; ++mt)
#pragma unroll
            for (int vt = 0; vt < 4; ++vt) { u32x2 pk; pk.x = cvt_pk_bf16(ob[mt][vt][0], ob[mt][vt][1]); pk.y = cvt_pk_bf16(ob[mt][vt][2], ob[mt][vt][3]);
                *(u32x2*)(optr + (size_t)(16 * mt + c16) * ostride + 16 * vt + 4 * g) = pk; }
    }
}

typedef float f32x16 __attribute__((ext_vector_type(16)));
typedef short s16x4 __attribute__((ext_vector_type(4)));
constexpr int DA_EM = 90112, DA_EMSTR = 272, DA_EMB = 32 * DA_EMSTR;
constexpr int DA_SLOT = 20480;
#define DA_SBAR() __builtin_amdgcn_sched_barrier(0)
#define DA_PIN(x) asm volatile("" : "+v"(x))
#define DA_WAIT_BAR() asm volatile("s_waitcnt vmcnt(0) lgkmcnt(0)\n\ts_barrier" ::: "memory")
__device__ __forceinline__ f32x16 mma32(bf16x8 rowop, bf16x8 colop, f32x16 c) { return __builtin_amdgcn_mfma_f32_32x32x16_bf16(rowop, colop, c, 0, 0, 0); }
__device__ __forceinline__ s16x4 da_vtr(const LAS uchar* p) { return __builtin_bit_cast(s16x4, __builtin_amdgcn_ds_read_tr16_b64_v4i16((LAS s16x4*)p)); }
__device__ __forceinline__ float da_swapmax(float v) { const auto rr = __builtin_amdgcn_permlane32_swap(__float_as_uint(v), __float_as_uint(v), false, false); return fmaxf(__uint_as_float(rr[0]), __uint_as_float(rr[1])); }
__device__ __forceinline__ float da_swapadd(float v) { const auto rr = __builtin_amdgcn_permlane32_swap(__float_as_uint(v), __float_as_uint(v), false, false); return __uint_as_float(rr[0]) + __uint_as_float(rr[1]); }
__device__ __forceinline__ void da_glds16(const void* g, unsigned lds_base) {
    unsigned sv; asm volatile("s_mov_b32 %0, m0\n\ts_mov_b32 m0, %2\n\ts_nop 0\n\tglobal_load_lds_dwordx4 %1, off\n\ts_mov_b32 m0, %0" : "=&s"(sv) : "v"(g), "s"(lds_base) : "memory"); }
__device__ __forceinline__ float da_rowmax(const f32x16& p0, const f32x16& p1) {
    float a = fmaxf(fmaxf(p0[0], p0[1]), p1[0]), b = fmaxf(fmaxf(p0[2], p0[3]), p1[1]); a = fmaxf(fmaxf(a, p1[2]), p1[3]);
#pragma unroll
    for (int r = 4; r < 16; r += 4) { a = fmaxf(fmaxf(a, p0[r]), p0[r + 1]); b = fmaxf(fmaxf(b, p0[r + 2]), p0[r + 3]); a = fmaxf(fmaxf(a, p1[r]), p1[r + 1]); b = fmaxf(fmaxf(b, p1[r + 2]), p1[r + 3]); }
    return da_swapmax(fmaxf(a, b)); }
__device__ __forceinline__ void dsa_ties(Frame& F);
__device__ __forceinline__ void dsa_attn(Frame& F, const bf16_t* qptr, const bf16_t* qrptr, bf16_t* optr, const bf16_t* kvbase, int ntiles, const bf16_t* wuvt) {
    const int lane = fresh_lane(); LAS uchar* L = F.lds; const int w = F.wave, r32 = lane & 31, hi = lane >> 5;
    const unsigned lds0 = (unsigned)(uintptr_t)L;
    const bf16_t* dsrc = kvbase + ((16 * (w & 3) + (lane >> 2)) * 160 + 8 * ((lane & 3) ^ ((lane >> 4) & 3)) + 32 * (w >> 2));
#define DA_DMA(kt, so) do { const bf16_t* s_ = dsrc + (size_t)(kt) * (64 * 160); const unsigned d_ = (unsigned)__builtin_amdgcn_readfirstlane((int)(lds0 + (so) + w * 1024)); \
        da_glds16(s_, d_); da_glds16(s_ + 64, d_ + 8192); if (w < 4) da_glds16(s_ + 128, d_ + 16384); } while (0)
    asm volatile("s_waitcnt lgkmcnt(0)\n\ts_barrier" ::: "memory");
    DA_DMA(0, 0); DA_DMA(1, DA_SLOT);
    bf16x8 qr[10];
#pragma unroll
    for (int d0 = 0; d0 < 8; ++d0) qr[d0] = *(const bf16x8*)(qptr + (size_t)r32 * 2048 + 16 * d0 + 8 * hi);
#pragma unroll
    for (int d0 = 8; d0 < 10; ++d0) qr[d0] = *(const bf16x8*)(qrptr + (size_t)r32 * 256 + 16 * (d0 - 8) + 8 * hi);
    const int fz = (r32 >> 2) & 3, kb0 = r32 * 64 + ((hi ^ fz) << 4), kb1 = kb0 ^ 32;
    const int vb0 = (4 * hi + ((lane & 15) >> 2)) * 64 + (((2 * ((lane >> 4) & 1) + ((lane & 3) >> 1)) ^ hi) << 4) + (lane & 1) * 8, vb1 = (vb0 ^ 32) + 512;
    const LAS uchar* emrd = L + DA_EM + r32 * DA_EMSTR + hi * 16;
#define DA_EMPROD(t) do { int pl_ = lane; asm volatile("" : "+v"(pl_)); const int pr_ = 4 * w + (pl_ >> 4), pk_ = pl_ & 15; \
        const int s_ = (int)(*(const LAS unsigned*)(L + AT_MASK + pr_ * (MK_STR * 4) + (pk_ >> 3) * 4 + (t) * 8) >> (4 * (pk_ & 7))); \
        *(LAS u32x4*)(L + DA_EM + pr_ * DA_EMSTR + pk_ * 16 + ((t) & 1) * DA_EMB) = (u32x4){(unsigned)__builtin_amdgcn_sbfe(s_, 0, 1), (unsigned)__builtin_amdgcn_sbfe(s_, 1, 1), (unsigned)__builtin_amdgcn_sbfe(s_, 2, 1), (unsigned)__builtin_amdgcn_sbfe(s_, 3, 1)}; } while (0)
#define DA_MRD(base, c) do { mr[(c) & 1] = *(const LAS u32x4*)((base) + ((c) >> 2) * 128 + ((c) & 3) * 32); } while (0)
    float m_reg, l_reg = 0.f, alpha = 1.f; bool resc = false;
    f32x16 o[4], pA0, pA1, pB0, pB1; u32x4 mr[2]; u32x4 pw0, pw1, pw2, pw3; bf16x8 kf[20]; s16x4 vlo[3], vhi[3];
    const f32x16 zero16 = {0.f, 0.f, 0.f, 0.f, 0.f, 0.f, 0.f, 0.f, 0.f, 0.f, 0.f, 0.f, 0.f, 0.f, 0.f, 0.f};
#pragma unroll
    for (int db = 0; db < 4; ++db) o[db] = zero16;
#define DA_KRD(base, d0) do { const LAS uchar* kp_ = (base) + (((d0) & 1) ? kb1 : kb0) + ((d0) >> 1) * 4096; kf[2 * (d0)] = *(const LAS bf16x8*)kp_; kf[2 * (d0) + 1] = *(const LAS bf16x8*)(kp_ + 2048); } while (0)
#define DA_VRD(base, i) do { vlo[(i) % 3] = da_vtr((base) + vb0 + ((i) >> 2) * 4096 + ((i) & 3) * 1024); vhi[(i) % 3] = da_vtr((base) + vb1 + ((i) >> 2) * 4096 + ((i) & 3) * 1024); } while (0)
#define DA_VF(i) (bf16x8){vlo[(i) % 3][0], vlo[(i) % 3][1], vlo[(i) % 3][2], vlo[(i) % 3][3], vhi[(i) % 3][0], vhi[(i) % 3][1], vhi[(i) % 3][2], vhi[(i) % 3][3]}
#define DA_PAF(k) __builtin_bit_cast(bf16x8, pw##k)
#define DA_BITPOS(r) (((r) & 3) + 8 * ((r) >> 2))
#define DA_FIN(P, r, c, e, PW, k) do { const float x0_ = __uint_as_float(__float_as_uint(P[r]) & mr[(c) & 1][e]), x1_ = __uint_as_float(__float_as_uint(P[(r) + 1]) & mr[(c) & 1][(e) + 1]); \
        sacc += x0_; sacc += x1_; PW[k] = cvt_pk_bf16(x0_, x1_); DA_PIN(PW); DA_PIN(sacc); } while (0)
#define DA_GAP(MFX, FILL) do { MFX; FILL; DA_SBAR(); } while (0)
#define DA_EX2(X, i) do { X[i] = __builtin_amdgcn_exp2f(X[i] + nm); X[(i) + 1] = __builtin_amdgcn_exp2f(X[(i) + 1] + nm); DA_PIN(X); } while (0)
#define DA_RESC() do { if (resc) { _Pragma("unroll") for (int db = 0; db < 4; ++db) _Pragma("unroll") for (int r = 0; r < 16; ++r) o[db][r] *= alpha; } } while (0)
    int slp = 0, slc = DA_SLOT, sln = 2 * DA_SLOT, sl2 = 3 * DA_SLOT;
#define DA_ROT() do { const int t_ = slp; slp = slc; slc = sln; sln = sl2; sl2 = t_; } while (0)
    dsa_ties(F);
    DA_WAIT_BAR();
    DA_DMA(2, 2 * DA_SLOT);
#pragma unroll
    for (int d0 = 0; d0 < 10; ++d0) DA_KRD(L, d0);
    pA0 = mma32(kf[0], qr[0], zero16); pA1 = mma32(kf[1], qr[0], zero16);
#pragma unroll
    for (int d0 = 1; d0 < 10; ++d0) { pA0 = mma32(kf[2 * d0], qr[d0], pA0); pA1 = mma32(kf[2 * d0 + 1], qr[d0], pA1); }
    m_reg = da_rowmax(pA0, pA1);
    { const float nm = -m_reg;
#pragma unroll
      for (int r = 0; r < 16; r += 2) { DA_EX2(pA0, r); DA_EX2(pA1, r); } }
    DA_EMPROD(0);
    DA_KRD(L + DA_SLOT, 0);
    DA_WAIT_BAR();
#define DA_STEP(C0, C1, P0, P1, t) do { DA_SBAR(); \
    { const LAS uchar* kc_ = L + slc; const LAS uchar* vp_ = L + slp; const LAS uchar* kn_ = L + sln; \
    { const int tn_ = (t) + 2 < 32 ? (t) + 2 : 31; DA_DMA(tn_, sl2); }                         \
    const LAS uchar* em_ = emrd + (((t) - 1) & 1) * DA_EMB; float sacc = 0.f; \
    DA_MRD(em_, 0); DA_MRD(em_, 1); DA_KRD(kc_, 1); DA_SBAR(); DA_GAP(C0 = mma32(kf[0], qr[0], zero16), (void)0); DA_GAP(C1 = mma32(kf[1], qr[0], zero16), (void)0); \
    DA_KRD(kc_, 2); DA_SBAR(); DA_GAP(C0 = mma32(kf[2], qr[1], C0), DA_FIN(P0, 0, 0, 0, pw0, 0)); DA_GAP(C1 = mma32(kf[3], qr[1], C1), DA_FIN(P0, 2, 0, 2, pw0, 1)); \
    DA_MRD(em_, 2); DA_KRD(kc_, 3); DA_SBAR(); DA_GAP(C0 = mma32(kf[4], qr[2], C0), DA_FIN(P0, 4, 1, 0, pw0, 2)); DA_GAP(C1 = mma32(kf[5], qr[2], C1), DA_FIN(P0, 6, 1, 2, pw0, 3)); \
    DA_MRD(em_, 3); DA_KRD(kc_, 4); DA_SBAR(); DA_GAP(C0 = mma32(kf[6], qr[3], C0), DA_FIN(P0, 8, 2, 0, pw1, 0)); DA_GAP(C1 = mma32(kf[7], qr[3], C1), DA_FIN(P0, 10, 2, 2, pw1, 1)); \
    DA_MRD(em_, 4); DA_KRD(kc_, 5); DA_SBAR(); DA_GAP(C0 = mma32(kf[8], qr[4], C0), DA_FIN(P0, 12, 3, 0, pw1, 2)); DA_GAP(C1 = mma32(kf[9], qr[4], C1), DA_FIN(P0, 14, 3, 2, pw1, 3)); \
    DA_MRD(em_, 5); DA_KRD(kc_, 6); DA_SBAR(); DA_GAP(C0 = mma32(kf[10], qr[5], C0), DA_FIN(P1, 0, 4, 0, pw2, 0)); DA_GAP(C1 = mma32(kf[11], qr[5], C1), DA_FIN(P1, 2, 4, 2, pw2, 1)); \
    DA_MRD(em_, 6); DA_KRD(kc_, 7); DA_SBAR(); DA_GAP(C0 = mma32(kf[12], qr[6], C0), DA_FIN(P1, 4, 5, 0, pw2, 2)); DA_GAP(C1 = mma32(kf[13], qr[6], C1), DA_FIN(P1, 6, 5, 2, pw2, 3)); \
    DA_MRD(em_, 7); DA_KRD(kc_, 8); DA_SBAR(); DA_GAP(C0 = mma32(kf[14], qr[7], C0), DA_FIN(P1, 8, 6, 0, pw3, 0)); DA_GAP(C1 = mma32(kf[15], qr[7], C1), DA_FIN(P1, 10, 6, 2, pw3, 1)); \
    DA_KRD(kc_, 9); DA_VRD(vp_, 0); DA_SBAR(); DA_GAP(C0 = mma32(kf[16], qr[8], C0), DA_FIN(P1, 12, 7, 0, pw3, 2)); DA_GAP(C1 = mma32(kf[17], qr[8], C1), DA_FIN(P1, 14, 7, 2, pw3, 3)); \
    DA_VRD(vp_, 1); DA_SBAR(); DA_GAP(C0 = mma32(kf[18], qr[9], C0), (void)0);                         DA_GAP(C1 = mma32(kf[19], qr[9], C1), (void)0); \
    l_reg += sacc; resc = false; \
    { const float rm = da_rowmax(C0, C1) - m_reg;                                                       \
      if (__builtin_expect(__any(rm > 8.0f), 0)) { const float dl = fmaxf(rm, 0.f); m_reg += dl; alpha = __builtin_amdgcn_exp2f(-dl); l_reg *= alpha; resc = true; } } \
    const float nm = -m_reg; DA_SBAR(); \
    DA_VRD(vp_, 2); DA_SBAR(); DA_GAP(o[0] = mma32(DA_VF(0), DA_PAF(0), o[0]), DA_EX2(C0, 0)); \
    DA_VRD(vp_, 3); DA_SBAR(); DA_GAP(o[0] = mma32(DA_VF(1), DA_PAF(1), o[0]), DA_EX2(C0, 2)); \
    DA_VRD(vp_, 4); DA_SBAR(); DA_GAP(o[0] = mma32(DA_VF(2), DA_PAF(2), o[0]), DA_EX2(C0, 4)); \
    DA_VRD(vp_, 5); DA_SBAR(); DA_GAP(o[0] = mma32(DA_VF(3), DA_PAF(3), o[0]), DA_EX2(C0, 6)); \
    DA_VRD(vp_, 6); DA_SBAR(); DA_GAP(o[1] = mma32(DA_VF(4), DA_PAF(0), o[1]), DA_EX2(C0, 8)); \
    DA_VRD(vp_, 7); DA_SBAR(); DA_GAP(o[1] = mma32(DA_VF(5), DA_PAF(1), o[1]), DA_EX2(C0, 10)); \
    DA_VRD(vp_, 8); DA_SBAR(); DA_GAP(o[1] = mma32(DA_VF(6), DA_PAF(2), o[1]), DA_EX2(C0, 12)); \
    DA_VRD(vp_, 9); DA_SBAR(); DA_GAP(o[1] = mma32(DA_VF(7), DA_PAF(3), o[1]), DA_EX2(C0, 14)); \
    DA_VRD(vp_, 10); DA_SBAR(); DA_GAP(o[2] = mma32(DA_VF(8), DA_PAF(0), o[2]), DA_EX2(C1, 0)); \
    DA_VRD(vp_, 11); DA_SBAR(); DA_GAP(o[2] = mma32(DA_VF(9), DA_PAF(1), o[2]), DA_EX2(C1, 2)); \
    DA_VRD(vp_, 12); DA_SBAR(); DA_GAP(o[2] = mma32(DA_VF(10), DA_PAF(2), o[2]), DA_EX2(C1, 4)); \
    DA_VRD(vp_, 13); DA_KRD(kn_, 0); DA_SBAR(); DA_GAP(o[2] = mma32(DA_VF(11), DA_PAF(3), o[2]), DA_EX2(C1, 6)); \
    DA_VRD(vp_, 14); DA_SBAR(); DA_GAP(o[3] = mma32(DA_VF(12), DA_PAF(0), o[3]), DA_EX2(C1, 8)); \
    DA_VRD(vp_, 15); DA_SBAR(); DA_GAP(o[3] = mma32(DA_VF(13), DA_PAF(1), o[3]), DA_EX2(C1, 10)); \
    DA_SBAR(); DA_GAP(o[3] = mma32(DA_VF(14), DA_PAF(2), o[3]), DA_EX2(C1, 12)); \
    DA_EMPROD(t); DA_SBAR(); DA_GAP(o[3] = mma32(DA_VF(15), DA_PAF(3), o[3]), DA_EX2(C1, 14)); \
    } DA_WAIT_BAR(); DA_RESC(); DA_ROT(); } while (0)
    for (int t = 1; t < ntiles; t += 2) { DA_STEP(pB0, pB1, pA0, pA1, t); DA_STEP(pA0, pA1, pB0, pB1, t + 1); }
#define DA_DRAIN(P0, P1, tl) do { const LAS uchar* em_ = emrd + ((tl) & 1) * DA_EMB; float sacc = 0.f; \
    DA_MRD(em_, 0); DA_MRD(em_, 1); DA_FIN(P0, 0, 0, 0, pw0, 0); DA_FIN(P0, 2, 0, 2, pw0, 1); DA_FIN(P0, 4, 1, 0, pw0, 2); DA_FIN(P0, 6, 1, 2, pw0, 3); \
    DA_MRD(em_, 2); DA_MRD(em_, 3); DA_FIN(P0, 8, 2, 0, pw1, 0); DA_FIN(P0, 10, 2, 2, pw1, 1); DA_FIN(P0, 12, 3, 0, pw1, 2); DA_FIN(P0, 14, 3, 2, pw1, 3); \
    DA_MRD(em_, 4); DA_MRD(em_, 5); DA_FIN(P1, 0, 4, 0, pw2, 0); DA_FIN(P1, 2, 4, 2, pw2, 1); DA_FIN(P1, 4, 5, 0, pw2, 2); DA_FIN(P1, 6, 5, 2, pw2, 3); \
    DA_MRD(em_, 6); DA_MRD(em_, 7); DA_FIN(P1, 8, 6, 0, pw3, 0); DA_FIN(P1, 10, 6, 2, pw3, 1); DA_FIN(P1, 12, 7, 0, pw3, 2); DA_FIN(P1, 14, 7, 2, pw3, 3); \
    l_reg += sacc; const LAS uchar* vp_ = L + slp; \
    _Pragma("unroll") for (int i = 0; i < 16; ++i) { DA_VRD(vp_, i); o[i >> 2] = mma32(DA_VF(i), (i & 3) == 0 ? DA_PAF(0) : ((i & 3) == 1 ? DA_PAF(1) : ((i & 3) == 2 ? DA_PAF(2) : DA_PAF(3))), o[i >> 2]); } } while (0)
    DA_DRAIN(pA0, pA1, 0);
#undef DA_DRAIN
#undef DA_STEP
#undef DA_ROT
#undef DA_RESC
#undef DA_EX2
#undef DA_GAP
#undef DA_FIN
#undef DA_MRD
#undef DA_EMPROD
#undef DA_BITPOS
#undef DA_PAF
#undef DA_VF
#undef DA_VRD
#undef DA_KRD
#undef DA_DMA
    const int lane_e = fresh_lane(), r32e = lane_e & 31, hie = lane_e >> 5;
    const float inv = 1.f / da_swapadd(l_reg);
    f32x16 ob[2]; ob[0] = zero16; ob[1] = zero16;
#pragma unroll
    for (int db = 0; db < 4; ++db)
#pragma unroll
        for (int s = 0; s < 2; ++s) {
            const bf16x8 bq = __builtin_bit_cast(bf16x8, (u32x4){cvt_pk_bf16(o[db][8 * s] * inv, o[db][8 * s + 1] * inv), cvt_pk_bf16(o[db][8 * s + 2] * inv, o[db][8 * s + 3] * inv),
                                                                 cvt_pk_bf16(o[db][8 * s + 4] * inv, o[db][8 * s + 5] * inv), cvt_pk_bf16(o[db][8 * s + 6] * inv, o[db][8 * s + 7] * inv)});
#pragma unroll
            for (int mb = 0; mb < 2; ++mb) { const bf16_t* wp = wuvt + (size_t)(32 * mb + r32e) * 128 + 32 * db + 16 * s + 4 * hie;
                const u32x2 a0 = *(const u32x2*)wp, a1 = *(const u32x2*)(wp + 8);
                ob[mb] = mma32(__builtin_bit_cast(bf16x8, (u32x4){a0.x, a0.y, a1.x, a1.y}), bq, ob[mb]); } }
#pragma unroll
    for (int mb = 0; mb < 2; ++mb)
#pragma unroll
        for (int rg = 0; rg < 4; ++rg) { u32x2 pk; pk.x = cvt_pk_bf16(ob[mb][4 * rg], ob[mb][4 * rg + 1]); pk.y = cvt_pk_bf16(ob[mb][4 * rg + 2], ob[mb][4 * rg + 3]);
            *(u32x2*)(optr + (size_t)r32e * 2048 + 32 * mb + 8 * rg + 4 * hie) = pk; }
}

__device__ __forceinline__ unsigned f2sortable(float x) { const unsigned u = __float_as_uint(x); return (u & 0x80000000u) ? ~u : (u | 0x80000000u); }
constexpr int IX_SC = 0, IX_H = AT_CNT + 512, IX_HSTR = 132  , IX_LST = IX_H + 16 * IX_HSTR * 4, IX_LCAP = 64;
static_assert(IX_LST + 16 * IX_LCAP * 4 <= MISC_OFF, "indexer LDS layout");
struct IxPre { bf16x8 qf[8][2]; float w8[8]; bf16x8 ka0, ka1, kb0, kb1; };
__device__ __forceinline__ void ix_prefetch(Frame& F, int b, int t0, IxPre& P) {
    const int lane = fresh_lane(); uchar* ws = F.ws; const int w = F.wave, g = lane >> 4, c16 = lane & 15;
    const size_t rowq = (size_t)b * SEQ + t0 + c16; const int tmax = t0 + 15;
    const bf16_t* KI = (const bf16_t*)(ws + WS_KIDX) + (size_t)(b >> 1) * XS_KIDX + (size_t)b * SEQ * 64;
    const bf16_t* QI = (const bf16_t*)(ws + WS_QI) + (size_t)(b >> 1) * XS_QI + rowq * 512 + 8 * g;
    const int ntl = tmax / 16 + 1; const int njw = (ntl > w) ? (ntl - w + 7) / 8 : 0; const int jmax = njw > 0 ? njw - 1 : 0;
#pragma unroll
    for (int hh = 0; hh < 8; ++hh) { P.qf[hh][0] = *(const bf16x8*)(QI + hh * 64); P.qf[hh][1] = *(const bf16x8*)(QI + hh * 64 + 32); }
    const f32x4 wA = *(const f32x4*)((const float*)(ws + WS_WIDX) + rowq * 8), wB = *(const f32x4*)((const float*)(ws + WS_WIDX) + rowq * 8 + 4);
    P.w8[0] = wA[0]; P.w8[1] = wA[1]; P.w8[2] = wA[2]; P.w8[3] = wA[3]; P.w8[4] = wB[0]; P.w8[5] = wB[1]; P.w8[6] = wB[2]; P.w8[7] = wB[3];
    const bf16_t* kp = KI + (size_t)(16 * w + c16) * 64 + 8 * g;
    P.ka0 = *(const bf16x8*)kp; P.ka1 = *(const bf16x8*)(kp + 32);
    P.kb0 = *(const bf16x8*)(kp + (size_t)(jmax > 0 ? 1 : 0) * 8192); P.kb1 = *(const bf16x8*)(kp + (size_t)(jmax > 0 ? 1 : 0) * 8192 + 32);
}
__device__ __forceinline__ void ix_score(Frame& F, int b, int t0, IxPre& P) {
    const int lane = fresh_lane(), tid = F.wave * 64 + lane;
    LAS uchar* L = F.lds; uchar* ws = F.ws; const int w = F.wave, g = lane >> 4, c16 = lane & 15;
    const int tq = t0 + c16, tmax = t0 + 15;
    const bf16_t* KI = (const bf16_t*)(ws + WS_KIDX) + (size_t)(b >> 1) * XS_KIDX + (size_t)b * SEQ * 64;
    const int ntl = tmax / 16 + 1;
    const int njw = (ntl > w) ? (ntl - w + 7) / 8 : 0;
    LAS u32x4* SC = (LAS u32x4*)(L + IX_SC) + tid;
    const bf16_t* kp = KI + (size_t)(16 * w + c16) * 64 + 8 * g;
    const int jmax = njw > 0 ? njw - 1 : 0;
#define IX_MMA(dst, k0_, k1_) do { _Pragma("unroll") for (int hh = 0; hh < 8; ++hh) { dst[hh] = mma16(k0_, P.qf[hh][0], (f32x4){0.f, 0.f, 0.f, 0.f}); dst[hh] = mma16(k1_, P.qf[hh][1], dst[hh]); } } while (0)
#define IX_SUM(src, jj) do { f32x4 sc = (f32x4){0.f, 0.f, 0.f, 0.f}; \
        _Pragma("unroll") for (int hh = 0; hh < 8; ++hh) { _Pragma("unroll") for (int r = 0; r < 4; ++r) { const int bi = __float_as_int(src[hh][r]); sc[r] += P.w8[hh] * __int_as_float(bi > 0 ? bi : 0); } } \
        const int kt_ = 16 * (8 * (jj) + w); u32x4 uv; \
        if (kt_ + 15 <= t0) { _Pragma("unroll") for (int r = 0; r < 4; ++r) uv[r] = f2sortable(sc[r]); }                      \
        else { _Pragma("unroll") for (int r = 0; r < 4; ++r) uv[r] = (kt_ + 4 * g + r <= tq) ? f2sortable(sc[r]) : 0u; } \
        SC[512 * (jj)] = uv; } while (0)
#pragma unroll 1
    for (int j = 0; j < njw; j += 2) {
        f32x4 accA[8], accB[8];
        IX_MMA(accA, P.ka0, P.ka1); IX_MMA(accB, P.kb0, P.kb1);
        __builtin_amdgcn_sched_barrier(0);
        { const int j2 = j + 2 < jmax ? j + 2 : jmax, j3 = j + 3 < jmax ? j + 3 : jmax;
          P.ka0 = *(const bf16x8*)(kp + (size_t)j2 * 8192); P.ka1 = *(const bf16x8*)(kp + (size_t)j2 * 8192 + 32); P.kb0 = *(const bf16x8*)(kp + (size_t)j3 * 8192); P.kb1 = *(const bf16x8*)(kp + (size_t)j3 * 8192 + 32); }
        __builtin_amdgcn_sched_barrier(0);
        IX_SUM(accA, j); IX_SUM(accB, j + 1);
    }
#undef IX_MMA
#undef IX_SUM
}
#define IX_LBAR() asm volatile("s_waitcnt lgkmcnt(0)\n\ts_barrier" ::: "memory")
__device__ __forceinline__ void ix_select(Frame& F, int t0, int mrow0) {
    const int lane = fresh_lane(), tid = F.wave * 64 + lane;
    LAS uchar* L = F.lds; const int w = F.wave, g = lane >> 4, c16 = lane & 15;
    const int tmax = t0 + 15;
    const int ntl = tmax / 16 + 1;
    const int njw = (ntl > w) ? (ntl - w + 7) / 8 : 0;
    LAS u32x4* SC = (LAS u32x4*)(L + IX_SC) + tid;
    unsigned T = 1u;
    if (tmax >= 256) {
        LAS unsigned* H = (LAS unsigned*)(L + IX_H); LAS unsigned* SELB = (LAS unsigned*)(L + AT_CNT) + (mrow0 ? 64 : 0); LAS unsigned* LCN = SELB + 32; LAS unsigned* LST = (LAS unsigned*)(L + IX_LST);
        if (tid < 16) { unsigned z0 = 0u, k256 = 256u; asm volatile("" : "+v"(z0), "+v"(k256)); SELB[2 * tid] = z0; SELB[2 * tid + 1] = k256; }
        if (tid < 17) LCN[tid] = 0u;
        unsigned prefix = 0u;
        const int l5 = lane & 31, tokw = 2 * w + (lane >> 5);
#define IX_PASS(p) do { const int shift = 24 - 8 * (p); \
        _Pragma("unroll 2") for (int j = 0; j < njw; ++j) { const u32x4 u4 = SC[512 * j]; \
            _Pragma("unroll") for (int r = 0; r < 4; ++r) { const unsigned u = u4[r]; const bool m = (p) > 0 ? (u != 0u && (u >> (shift + 8)) == prefix) : true;     const unsigned bin = (u >> shift) & 255u; \
                __hip_atomic_fetch_add(&H[c16 * IX_HSTR + (m ? (bin >> 1) : 128u + r)], 1u << (16 * (bin & 1u)), __ATOMIC_RELAXED, __HIP_MEMORY_SCOPE_WORKGROUP); } } \
        IX_LBAR(); \
        { LAS u32x4* hp = (LAS u32x4*)(H + tokw * IX_HSTR + 4 * l5); const u32x4 hw = *hp; *hp = (u32x4){0u, 0u, 0u, 0u};           \
          const unsigned c[8] = {hw.x & 0xffffu, hw.x >> 16, hw.y & 0xffffu, hw.y >> 16, hw.z & 0xffffu, hw.z >> 16, hw.w & 0xffffu, hw.w >> 16}; \
          const unsigned sl = ((c[0] + c[1]) + (c[2] + c[3])) + ((c[4] + c[5]) + (c[6] + c[7])); unsigned suf = sl; \
          _Pragma("unroll") for (int o = 1; o < 32; o <<= 1) { const unsigned t = (unsigned)__builtin_amdgcn_ds_bpermute((l5 + o < 32 ? lane + o : lane) << 2, (int)suf); if (l5 + o < 32) suf += t; } \
          const unsigned kr = SELB[2 * tokw + 1], excl = suf - sl; LDS_WAIT(); \
          if (excl < kr && kr <= suf) { unsigned above = excl, bin = 0u; bool found = false; \
              _Pragma("unroll") for (int q = 7; q >= 0; --q) { if (!found) { if (above + c[q] >= kr) { bin = (unsigned)q; found = true; } else above += c[q]; } } \
              SELB[2 * tokw] = 8u * l5 + bin; SELB[2 * tokw + 1] = kr - above; } } \
        IX_LBAR(); \
        prefix = (prefix << 8) | SELB[2 * c16]; } while (0)
        IX_PASS(0); IX_PASS(1);
#pragma unroll 2
        for (int j = 0; j < njw; ++j) { const u32x4 u4 = SC[512 * j];
#pragma unroll
            for (int r = 0; r < 4; ++r) { const unsigned u = u4[r];
                if (u != 0u && (u >> 16) == prefix) { const unsigned pos = __hip_atomic_fetch_add(&LCN[c16], 1u, __ATOMIC_RELAXED, __HIP_MEMORY_SCOPE_WORKGROUP);
                    if (pos < (unsigned)IX_LCAP) LST[c16 * IX_LCAP + pos] = u; else LCN[16] = 1u; } } }
        IX_LBAR();
        if (__builtin_amdgcn_readfirstlane(LCN[16]) == 0u) {
            const unsigned lenA = __builtin_amdgcn_readfirstlane(LCN[2 * w]), lenB = __builtin_amdgcn_readfirstlane(LCN[2 * w + 1]);
            if (lenA <= 32u && lenB <= 32u) {
                const unsigned len = (lane >> 5) ? lenB : lenA, lmax = lenA > lenB ? lenA : lenB, kr = SELB[2 * tokw + 1];
                const unsigned e = ((unsigned)l5 < len) ? LST[tokw * IX_LCAP + l5] : 0xffffffffu; unsigned G = 0u, E = 0u;
                for (unsigned k = 0; k < lmax; ++k) { const unsigned xr = LST[tokw * IX_LCAP + k]; const unsigned x = k < len ? xr : 0u; G += x > e ? 1u : 0u; E += x == e ? 1u : 0u; }
                LDS_WAIT();
                if ((unsigned)l5 < len && G < kr && kr <= G + E) SELB[2 * tokw] = e;
            } else {
#pragma unroll 1
            for (int tt = 0; tt < 2; ++tt) { const int tok = 2 * w + tt; const unsigned len = __builtin_amdgcn_readfirstlane(LCN[tok]), kr = __builtin_amdgcn_readfirstlane(SELB[2 * tok + 1]);
                const unsigned e = (lane < (int)len) ? LST[tok * IX_LCAP + lane] : 0xffffffffu; unsigned G = 0u, E = 0u;
                for (unsigned k = 0; k < len; ++k) { const unsigned x = LST[tok * IX_LCAP + k]; G += x > e ? 1u : 0u; E += x == e ? 1u : 0u; }
                LDS_WAIT();
                if (lane < (int)len && G < kr && kr <= G + E) SELB[2 * tok] = e;
            }
            }
            IX_LBAR();
            T = SELB[2 * c16];
        } else {
            IX_PASS(2); IX_PASS(3);
            T = prefix;
        }
#undef IX_PASS
    }
    LAS unsigned* MK = (LAS unsigned*)(L + AT_MASK) + (mrow0 + c16) * MK_STR; LAS unsigned* EQ = (LAS unsigned*)(L + AT_EQM) + (mrow0 + c16) * MK_STR;
    const int sh = 16 * (w & 1) + 4 * g;
#pragma unroll 2
    for (int j = 0; j < njw; ++j) { const u32x4 u4 = SC[512 * j]; unsigned ngt = 0u, neq = 0u;
#pragma unroll
        for (int r = 0; r < 4; ++r) { ngt |= (u4[r] > T ? 1u : 0u) << r; neq |= (u4[r] == T ? 1u : 0u) << r; }
        if (T == 1u) { ngt |= neq; neq = 0u; }
        if (ngt) __hip_atomic_fetch_or(&MK[4 * j + (w >> 1)], ngt << sh, __ATOMIC_RELAXED, __HIP_MEMORY_SCOPE_WORKGROUP);
        if (neq) __hip_atomic_fetch_or(&EQ[4 * j + (w >> 1)], neq << sh, __ATOMIC_RELAXED, __HIP_MEMORY_SCOPE_WORKGROUP); }
}
__device__ __forceinline__ void dsa_ties(Frame& F) {
    const int lane = fresh_lane(), tid = F.wave * 64 + lane; LAS uchar* L = F.lds;
    const int tok = tid >> 4, part = lane & 15;
    LAS u32x2* mk = (LAS u32x2*)((LAS unsigned*)(L + AT_MASK) + tok * MK_STR + 4 * part); LAS u32x2* eq = (LAS u32x2*)((LAS unsigned*)(L + AT_EQM) + tok * MK_STR + 4 * part);
    const u32x2 m0 = mk[0], m1 = mk[1], e0 = eq[0], e1 = eq[1];
    int n = (__popc(m0.x) + __popc(m0.y)) + (__popc(m1.x) + __popc(m1.y));
    const unsigned ew[4] = {e0.x, e0.y, e1.x, e1.y};
    const int ce = (__popc(ew[0]) + __popc(ew[1])) + (__popc(ew[2]) + __popc(ew[3]));
    int inc = ce;
#pragma unroll
    for (int o = 1; o < 16; o <<= 1) { n += (int)shxu((unsigned)n, o, lane); const int t = __builtin_amdgcn_ds_bpermute((part >= o ? lane - o : lane) << 2, inc); if (part >= o) inc += t; }
    int take = 256 - n - (inc - ce);
    take = take < 0 ? 0 : (take > ce ? ce : take);
    unsigned sel[4];
#pragma unroll
    for (int i = 0; i < 4; ++i) { const int c = __popc(ew[i]);
        if (take >= c) { sel[i] = ew[i]; take -= c; }
        else { unsigned keep = 0u, e = ew[i]; for (int q = 0; q < take; ++q) { const unsigned low = e & (0u - e); keep |= low; e ^= low; } sel[i] = keep; take = 0; } }
    if (ce) { mk[0] = (u32x2){m0.x | sel[0], m0.y | sel[1]}; mk[1] = (u32x2){m1.x | sel[2], m1.y | sel[3]}; }
}
__device__ __forceinline__ void dsa_unit(Frame& F, int b, int qt) {
    const int tid = F.wave * 64 + fresh_lane();
    LAS uchar* L = F.lds; uchar* ws = F.ws; const int w = F.wave; const int tq0 = 32 * qt;
    IxPre P;
    ix_prefetch(F, b, tq0, P);
    IX_LBAR();
    for (int o = tid * 16; o < 2 * 32 * MK_STR * 4; o += NTHR * 16) *(LAS u32x4*)(L + AT_MASK + o) = (u32x4){0u, 0u, 0u, 0u};
    for (int o = tid * 16; o < 16 * IX_HSTR * 4; o += NTHR * 16) *(LAS u32x4*)(L + IX_H + o) = (u32x4){0u, 0u, 0u, 0u};
    IX_LBAR();
    ix_score(F, b, tq0, P);
    ix_prefetch(F, b, tq0 + 16, P);
    ix_select(F, tq0, 0);
    ix_score(F, b, tq0 + 16, P);
    ix_select(F, tq0 + 16, 16);
    bf16_t* OALL = (bf16_t*)F.out; const size_t row0 = (size_t)b * SEQ + tq0;
    bf16_t* op = OALL + row0 * 2048 + 512 + w * 64;
    dsa_attn(F, OALL + row0 * 2048 + 512 + w * 128, (const bf16_t*)(ws + WS_QR) + (size_t)(b >> 1) * XS_QR + row0 * 256 + w * 32, op, (const bf16_t*)(ws + WS_KV) + (size_t)(b >> 1) * XS_KV + (size_t)b * SEQ * 160, (tq0 + 31) / 64 + 1, (const bf16_t*)(ws + WS_WUVT) + (size_t)w * 8192);
}
__device__ __forceinline__ void mem_unit(Frame& F, int b, int h, int tb) {
    uchar* ws = F.ws; bf16_t* OALL = (bf16_t*)F.out; const size_t row0 = (size_t)b * SEQ + tb * 256 + 32 * F.wave;
    const bf16_t* km = (const bf16_t*)(ws + WS_KM) + (size_t)(b >> 1) * XS_KM + (size_t)b * MEMLEN * 1024 + h * 128;
    __syncthreads();
    bf16_t* op = OALL + row0 * 2048 + 1536 + h * 128;
    attn_unit<false, false>(F, OALL + row0 * 2048 + 1536 + h * 128, 2048, op, 2048, nullptr, 0, km, 1024, km + 512, 1024, 4);
}

__global__ void __launch_bounds__(NTHR, 2) fwd_kernel(Args args) {
    extern __shared__ __attribute__((aligned(16))) uchar lds_raw[];
    Frame F; F.lds = (LAS uchar*)lds_raw; F.wave = __builtin_amdgcn_readfirstlane(threadIdx.x >> 6);
    F.G = gridDim.x; F.c = blockIdx.x; F.vcu = (F.G % 8 == 0) ? (F.c % 8) * (F.G / 8) + F.c / 8 : F.c;
    F.in = args.in; F.out = args.out; F.ws = args.ws;
    uchar* ws = args.ws;
    volatile LAS unsigned* MISC = (volatile LAS unsigned*)(F.lds + MISC_OFF);
    if (threadIdx.x < 64) MISC[threadIdx.x] = 0u;
    __syncthreads();
    XcdBarrier bar = xcd_barrier_post((unsigned*)(ws + WS_CTL) + CW_BAR, MISC + 8);

    p0_prologue(F);
    xcd_barrier(bar, F.wave);
    const bool xmode = __builtin_amdgcn_readfirstlane((int)MISC[10]) != 0;
    const int cs = xmode ? __builtin_amdgcn_readfirstlane((int)MISC[12]) * 8 + __builtin_amdgcn_readfirstlane((int)MISC[13]) : F.c;
    p1_w8_all(F);
    asm volatile("s_waitcnt vmcnt(0)" ::: "memory"); __syncthreads();
    if (threadIdx.x == 0) { __builtin_amdgcn_fence(__ATOMIC_RELEASE, "agent"); asm volatile("s_waitcnt vmcnt(0)" ::: "memory"); __hip_atomic_fetch_add((unsigned*)(ws + WS_CTL) + CW_W8DONE, 1u, __ATOMIC_RELAXED, __HIP_MEMORY_SCOPE_AGENT); }
    {
        pg8::Gemm g{(const bf16_t*)(ws + WS_XB), (const bf16_t*)(ws + WS_WIN), 1024, 1024};
        pg8::TileSched S{128, 2, 8, F.G, cs, 16};
        EpiProj E{(const float*)(ws + WS_RSX), (bf16_t*)F.out, (bf16_t*)(ws + WS_HQ), (float*)(ws + WS_G), (bf16_t*)(ws + WS_HV), (bf16_t*)(ws + WS_HV) + 512, (bf16_t*)(ws + WS_CQ), (float*)(ws + WS_CQSS), (float*)(ws + WS_R9), ws + WS_GATES, (const float*)(ws + WS_LB)};
        pg8::gemm_phase(F.lds, F.wave, g, S, E);
    }
    xcd_barrier(bar, F.wave, xmode);
    if (xmode) p2_xq_rows<true>(F, ws + WS_XB, ws + WS_XB, 2048, 4096 * (cs & 7), 4096, (cs >> 3) * NWAVES + F.wave, 32 * NWAVES); else p2_xq_rows<true>(F, ws + WS_XB, ws + WS_XB, 2048, 0, MTOK, F.c * NWAVES + F.wave, F.G * NWAVES);
    if (threadIdx.x == 0) { unsigned sp = 0u; while (__hip_atomic_load((unsigned*)(ws + WS_CTL) + CW_W8DONE, __ATOMIC_RELAXED, __HIP_MEMORY_SCOPE_AGENT) < (unsigned)F.G) { __builtin_amdgcn_s_sleep(2); if (++sp > (1u << 22)) break; } }
    xcd_barrier(bar, F.wave, xmode);
    {
        pg8::Gemm g{(const bf16_t*)(ws + WS_XB), (const bf16_t*)(ws + WS_W8P), 1024, 512};
        pg8::ProjSched S{pg8::TileSched{128, 10, 0, F.G, cs, 8}};
        EpiProj8 E{EpiProj{(const float*)(ws + WS_RSX), (bf16_t*)F.out, (bf16_t*)(ws + WS_HQ), (float*)(ws + WS_G), (bf16_t*)(ws + WS_HV), (bf16_t*)(ws + WS_HV) + 512, (bf16_t*)(ws + WS_CQ), (float*)(ws + WS_CQSS), (float*)(ws + WS_R9), ws + WS_GATES, (const float*)(ws + WS_LB)},
                   (const float*)(ws + WS_SXQ), (const float*)(ws + WS_SWP)};
        pg8::gemm_phase(F.lds, F.wave, g, S, E);
    }
    xcd_barrier(bar, F.wave, xmode);
    { const int xx = cs & 7, rk = cs >> 3;
      const bool hgrole = xmode ? rk < 8 : F.c < 64;
    if (hgrole) { hgrn_chain(F, xmode ? (2 * xx + (rk >> 2)) * 4 + (rk & 3) : F.c);
    }
    else {
        const int G2 = F.G - 64, c2 = F.c - 64, r2 = rk - 8;
        { const int lane = fresh_lane();
          if (xmode) { for (int i = r2 * NWAVES + F.wave; i < 512; i += 24 * NWAVES) kv_prep_grp(F, 512 * xx + i, lane); }
          else { for (int grp = c2 * NWAVES + F.wave; grp < MTOK / 8; grp += G2 * NWAVES) kv_prep_grp(F, grp, lane); } }
        { pg8::Gemm g{(const bf16_t*)(ws + WS_MB), (const bf16_t*)(ws + WS_WKV), 1024, 1024}; pg8::XcdSched S{xmode, pg8::TileSched{16, 4, 0, 64, c2 - 128, 16}, xx, r2 - 16, 8, 2, 4, 0, 16};     EpiKvm E{(const float*)(ws + WS_RSM), (bf16_t*)(ws + WS_KM)};
          pg8::gemm_phase(F.lds, F.wave, g, S, E); }
        { pg8::Gemm g{(const bf16_t*)(ws + WS_CQ), (const bf16_t*)(ws + WS_WDQ), 256, 256, XS_CQ * 2}; pg8::XcdSched S{xmode, pg8::TileSched{128, 7, 0, G2, c2, 4}, xx, r2, 24, 16, 7, 0, 4};
          EpiDq E{(const float*)(ws + WS_CQSS), (bf16_t*)F.out, (bf16_t*)(ws + WS_QR), (bf16_t*)(ws + WS_QI), (const float*)(ws + WS_TAB32), (const float*)(ws + WS_TAB64)};
          pg8::gemm_phase(F.lds, F.wave, g, S, E); }
        { pg8::Gemm g{(const bf16_t*)(ws + WS_XB), (const bf16_t*)(ws + WS_W8), 1024, 512}; pg8::GateSched S{xmode, pg8::TileSched{128, 12, 0, G2, c2, 8}, xx, r2};
          EpiGate8 E{(const float*)(ws + WS_RSX), (const float*)(ws + WS_SXQ), (const float*)(ws + WS_SW), ws + WS_GATES};
          pg8::gemm_phase(F.lds, F.wave, g, S, E); }
    } }
    xcd_barrier(bar, F.wave, xmode);
    { const int P0i = xmode ? 64 * (cs & 7) + (cs >> 3) : F.vcu, Pst = xmode ? 32 : F.G, Pn = xmode ? 2 : (F.vcu < 512 ? (511 - F.vcu) / F.G + 1 : 0);
_Pragma("unroll 1")
      for (int k = 0; k < Pn; ++k) { const int P = P0i + k * Pst, b = P >> 5, x = P & 31;
_Pragma("unroll 1")
        for (int s = 0; s < 2; ++s) dsa_unit(F, b, s ? 63 - x : x); }
_Pragma("unroll 1")
      for (int k = 0; k < Pn; ++k) { const int P = P0i + k * Pst, b = P >> 5, h = (P >> 3) & 3, tb = P & 7; mem_unit(F, b, h, tb); } }
    xcd_barrier(bar, F.wave, xmode);
    { pg8::Gemm g{(const bf16_t*)F.out, (const bf16_t*)(ws + WS_BALL), 2048, 2048}; pg8::MergeSched S{F.G, cs}; EpiMerge E{ws + WS_GATES, (bf16_t*)(ws + WS_MERGED)};
      pg8::gemm_phase(F.lds, F.wave, g, S, E);
    }
    xcd_barrier(bar, F.wave, xmode);
    { pg8::Gemm g{(const bf16_t*)(ws + WS_MERGED), (const bf16_t*)(ws + WS_WOUT), 1024, 1024}; pg8::TileSched S{128, 4, 0, F.G, cs, 16};
      EpiOut E{F.in[0], (bf16_t*)(ws + WS_H1B), (float*)(ws + WS_H1SS)};
      pg8::gemm_phase(F.lds, F.wave, g, S, E);
    }
    xcd_barrier(bar, F.wave, xmode);
    if (xmode) p2_xq_rows(F, ws + WS_H1B, ws + WS_XB, 2048, 4096 * (cs & 7), 4096, (cs >> 3) * NWAVES + F.wave, 32 * NWAVES); else p2_xq_rows(F, ws + WS_H1B, ws + WS_XB, 2048, 0, MTOK, F.c * NWAVES + F.wave, F.G * NWAVES);
    xcd_barrier(bar, F.wave, xmode);
    if (xmode && ((cs >> 3) & 1)) { __builtin_amdgcn_s_sleep(127); __builtin_amdgcn_s_sleep(127); }
    { pg8::Gemm g{(const bf16_t*)(ws + WS_XB), (const bf16_t*)(ws + WS_WUP), 1024, 512}; pg8::UpSched S{xmode, pg8::TileSched{128, 16, 0, F.G, cs, 8}, cs & 7, cs >> 3};
      EpiUp8 E{(bf16_t*)(ws + WS_U), (const float*)(ws + WS_H1SS), (float*)(ws + WS_S2), (const float*)(ws + WS_SXQ), (const float*)(ws + WS_SWU)};
      pg8::gemm_phase(F.lds, F.wave, g, S, E);
    }
    xcd_barrier(bar, F.wave, xmode);
    { pg8::Gemm g{(const bf16_t*)(ws + WS_U), (const bf16_t*)(ws + WS_WDOWN), 4096, 4096}; pg8::TileSched S{128, 4, 0, F.G, cs, 64};
      EpiDownNorm E{F.out, (const bf16_t*)(ws + WS_H1B), (const float*)(ws + WS_S2), F.in[23], (unsigned*)(ws + WS_XCH), (unsigned*)(ws + WS_CTL) + CW_PANEL, F.lds + 131072};
      pg8::gemm_phase(F.lds, F.wave, g, S, E);
    }
}

extern "C" void kernel_launch(void* const* d_in, const int* in_sizes, int n_in, void* d_out, int out_size, void* d_ws, size_t ws_size, hipStream_t stream) {
    static int grid = 0;
    if (grid == 0) {
        if (n_in != 24 || out_size != MTOK * DM || ws_size < WS_END) { fprintf(stderr, "kernel_launch: unexpected shapes (n_in %d, out %d, ws %zu)\n", n_in, out_size, ws_size); grid = -1; return; }
        int dev = 0, cus = 0;
        if (hipGetDevice(&dev) != hipSuccess || hipDeviceGetAttribute(&cus, hipDeviceAttributeMultiprocessorCount, dev) != hipSuccess) { grid = -1; return; }
        if (hipFuncSetAttribute((const void*)fwd_kernel, hipFuncAttributeMaxDynamicSharedMemorySize, LDS_BYTES) != hipSuccess) { fprintf(stderr, "kernel_launch: hipFuncSetAttribute failed\n"); grid = -1; return; }
        (void)hipGetLastError();
        grid = cus;
        if (grid != 256) fprintf(stderr, "kernel_launch: built for 256 CUs, device has %d\n", cus);
    }
    if (grid < 0) return;
    (void)hipMemsetAsync((char*)d_ws + WS_CTL, 0, CTL_ZERO_BYTES, stream);
    Args a{};
    for (int i = 0; i < 24; ++i) a.in[i] = (const float*)d_in[i];
    a.out = (float*)d_out; a.ws = (uchar*)d_ws;
    hipLaunchKernelGGL(fwd_kernel, dim3(grid), dim3(NTHR), LDS_BYTES, stream, a);
}
```
